# Optimizing an MI355X kernel written in HIP

```python
import jax
import jax.numpy as jnp
from jax import lax
import numpy as np

D_MODEL = 2048
BATCH = 4
SEQ = 2048
DEPTH = 1
DEC_BATCH = 16
DEC_SEQ = 64
PAST_LEN = 4096

CHUNK = 64
MIX_WIDTH = D_MODEL
GLA_WIDTH = MIX_WIDTH // 2
GLA_HEADS = 4
GLA_DV = GLA_WIDTH // GLA_HEADS
GLA_DK = GLA_DV // 2
GLA_GATE_RANK = 16
GLA_GATE_NORM = 16.0
GDN_WIDTH = MIX_WIDTH - GLA_WIDTH
GDN_HEADS = 8
GDN_DV = GDN_WIDTH // GDN_HEADS
GDN_DK = 128
GDN_CONV = 4
GDN_CONV_DIM = 2 * GDN_HEADS * GDN_DK + GDN_WIDTH
D_FF = 5632
FFN_CONV = 3
N_MOD = 6
EPS = 1e-6
IN_SIZES = (GLA_HEADS * GLA_DK, GLA_HEADS * GLA_DK, GLA_WIDTH, GLA_WIDTH, GLA_GATE_RANK,
            GDN_HEADS * GDN_DK, GDN_HEADS * GDN_DK, GDN_WIDTH, GDN_WIDTH, GDN_HEADS, GDN_HEADS)
D_IN = sum(IN_SIZES)
IN_OFFSETS = tuple(int(v) for v in np.cumsum(IN_SIZES)[:-1])

kernel_name = 'hymba_gla_gdn_convglu_adaln_stream'


def rmsnorm(x, gain):
    xf = x.astype(jnp.float32)
    y = xf * lax.rsqrt(jnp.mean(xf * xf, axis=-1, keepdims=True) + EPS)
    return (y * gain.astype(jnp.float32)).astype(x.dtype)


def l2norm(x):
    return x * lax.rsqrt(jnp.sum(x * x, axis=-1, keepdims=True) + EPS)


def causal_dwconv(x, buf, w):
    k_w, seq = w.shape[0], x.shape[1]
    xp = jnp.concatenate([buf.astype(x.dtype), x], axis=1)
    y = xp[:, 0:seq] * w[0]
    for i in range(1, k_w):
        y = y + xp[:, i:i + seq] * w[i]
    return y, xp[:, seq:]


def to_heads(t, n_heads):
    b, l, _ = t.shape
    return t.reshape(b, l, n_heads, -1).transpose(0, 2, 1, 3).astype(jnp.float32)


def from_heads(o, gain):
    b, h, l, d = o.shape
    o = o.transpose(0, 2, 1, 3)
    o = o * lax.rsqrt(jnp.mean(o * o, axis=-1, keepdims=True) + EPS) * gain.astype(jnp.float32)
    return o.reshape(b, l, h * d)


def blocked_recurrence(step, s0, seqs, block):
    b, h, l = seqs[0].shape[:3]
    n = l // block
    xs = tuple(jnp.moveaxis(a.reshape(b, h, n, block, a.shape[-1]), 2, 0) for a in seqs)
    s, o = lax.scan(step, s0.astype(jnp.float32), xs)
    o = jnp.moveaxis(o, 0, 2).reshape(b, h, l, o.shape[-1])
    return o, s


def gla_step(s, blk):
    q, k, v, g = blk
    c = q.shape[2]
    big_g = jnp.cumsum(g, axis=2)
    causal = jnp.tril(jnp.ones((c, c), dtype=bool))
    diff = big_g[:, :, :, None, :] - big_g[:, :, None, :, :]
    decay = jnp.exp(jnp.where(causal[:, :, None], diff, -jnp.inf))
    attn = jnp.einsum('bhid,bhjd,bhijd->bhij', q, k, decay)
    o = (jnp.einsum('bhij,bhjv->bhiv', attn, v)
         + jnp.einsum('bhid,bhdv->bhiv', q * jnp.exp(big_g), s))
    g_last = big_g[:, :, -1:, :]
    s_new = (jnp.exp(g_last[:, :, 0, :, None]) * s
             + jnp.einsum('bhjd,bhjv->bhdv', k * jnp.exp(g_last - big_g), v))
    return s_new, o


def gdn_step(s, blk):
    q, k, v, g, beta = blk
    c, dv = q.shape[2], v.shape[-1]
    big_g = jnp.cumsum(g[..., 0], axis=-1)
    causal = jnp.tril(jnp.ones((c, c), dtype=bool))
    strict = jnp.tril(jnp.ones((c, c), dtype=bool), -1)
    decay = jnp.exp(jnp.where(causal, big_g[..., :, None] - big_g[..., None, :], -jnp.inf))
    kb = k * beta
    lower = jnp.where(strict, jnp.einsum('bhid,bhjd->bhij', kb, k) * decay, 0.0)
    eye = jnp.eye(c, dtype=jnp.float32)
    rhs = jnp.concatenate([v * beta, kb * jnp.exp(big_g)[..., None]], axis=-1)
    sol = lax.linalg.triangular_solve(eye + lower, rhs, left_side=True, lower=True,
                                      unit_diagonal=True)
    u = sol[..., :dv] - jnp.einsum('bhik,bhkv->bhiv', sol[..., dv:], s)
    attn = jnp.einsum('bhid,bhjd->bhij', q, k) * decay
    o = (jnp.einsum('bhid,bhdv->bhiv', q * jnp.exp(big_g)[..., None], s)
         + jnp.einsum('bhij,bhjv->bhiv', attn, u))
    g_last = big_g[..., -1:]
    s_new = (jnp.exp(g_last)[..., None] * s
             + jnp.einsum('bhjd,bhjv->bhdv', k * jnp.exp(g_last - big_g)[..., None], u))
    return s_new, o


def token_mixers(h, st_gla, st_gdn, st_conv, w_in, gla_wg, gla_bg, gla_norm, gdn_conv_w,
                 gdn_a_log, gdn_dt_bias, gdn_norm, w_out, block):
    f32 = jnp.float32
    proj = h @ w_in
    (a_q, a_k, a_v, a_r, a_lr, b_q, b_k, b_v, b_g, b_beta, b_alpha) = jnp.split(
        proj, IN_OFFSETS, axis=-1)
    log_a = jax.nn.log_sigmoid((a_lr @ gla_wg + gla_bg).astype(f32)) / GLA_GATE_NORM
    o_a, s_gla = blocked_recurrence(
        gla_step, st_gla,
        (to_heads(a_q, GLA_HEADS) * GLA_DK ** -0.5, to_heads(a_k, GLA_HEADS),
         to_heads(a_v, GLA_HEADS), to_heads(log_a, GLA_HEADS)), block)
    o_a = from_heads(o_a, gla_norm) * jax.nn.silu(a_r.astype(f32))
    qkv, conv_new = causal_dwconv(jnp.concatenate([b_q, b_k, b_v], axis=-1), st_conv, gdn_conv_w)
    qkv = jax.nn.silu(qkv)
    c_q, c_k, c_v = jnp.split(qkv, [GDN_HEADS * GDN_DK, 2 * GDN_HEADS * GDN_DK], axis=-1)
    q = l2norm(to_heads(c_q, GDN_HEADS)) * GDN_DK ** -0.5
    k = l2norm(to_heads(c_k, GDN_HEADS))
    v = to_heads(c_v, GDN_HEADS)
    beta = jax.nn.sigmoid(to_heads(b_beta, GDN_HEADS))
    g = -jnp.exp(gdn_a_log.astype(f32))[:, None, None] * jax.nn.softplus(
        to_heads(b_alpha, GDN_HEADS) + gdn_dt_bias.astype(f32)[:, None, None])
    o_b, s_gdn = blocked_recurrence(gdn_step, st_gdn, (q, k, v, g, beta), block)
    o_b = from_heads(o_b, gdn_norm) * jax.nn.silu(b_g.astype(f32))
    out = jnp.concatenate([o_a, o_b], axis=-1).astype(h.dtype) @ w_out
    return out, s_gla, s_gdn, conv_new


def conv_ffn(h, st, w_up, ffn_conv_w, ffn_conv_b, w_down):
    gate, val = jnp.split(h @ w_up, 2, axis=-1)
    gate_c, new_st = causal_dwconv(gate, st, ffn_conv_w)
    act = jax.nn.silu(gate_c + ffn_conv_b) * val
    return act @ w_down, new_st


def trunk(x, c, states, params, block):
    (w_ada, b_ada, norm1, w_in, gla_wg, gla_bg, gla_norm, gdn_conv_w, gdn_a_log, gdn_dt_bias,
     gdn_norm, w_out, norm2, w_up, ffn_conv_w, ffn_conv_b, w_down, final_norm) = params
    gla_s, gdn_s, conv_s, ffn_s = states
    n_gla, n_gdn, n_conv, n_ffn = [], [], [], []
    for l in range(DEPTH):
        mod = jax.nn.silu(c) @ w_ada[l] + b_ada[l]
        sh1, sc1, g1, sh2, sc2, g2 = jnp.split(mod[:, None, :], N_MOD, axis=-1)
        h = rmsnorm(x, norm1[l]) * (1 + sc1) + sh1
        mix, s_a, s_b, s_c = token_mixers(
            h, gla_s[l], gdn_s[l], conv_s[l], w_in[l], gla_wg[l], gla_bg[l], gla_norm[l],
            gdn_conv_w[l], gdn_a_log[l], gdn_dt_bias[l], gdn_norm[l], w_out[l], block)
        x = x + g1 * mix
        h = rmsnorm(x, norm2[l]) * (1 + sc2) + sh2
        f, s_f = conv_ffn(h, ffn_s[l], w_up[l], ffn_conv_w[l], ffn_conv_b[l], w_down[l])
        x = x + g2 * f
        n_gla.append(s_a)
        n_gdn.append(s_b)
        n_conv.append(s_c)
        n_ffn.append(s_f)
    y = rmsnorm(x, final_norm)
    return y, jnp.stack(n_gla), jnp.stack(n_gdn), jnp.stack(n_conv), jnp.stack(n_ffn)


def setup_inputs(seed: int = 0) -> dict:
    key = jax.random.key(seed)
    ks = jax.random.split(key, 32)
    f32 = jnp.float32

    def nrm(k, shape, scale):
        return jax.random.normal(k, shape, f32) * scale

    d = D_MODEL
    dt = jnp.exp(jax.random.uniform(ks[15], (DEPTH, GDN_HEADS), f32,
                                    minval=float(np.log(1e-3)), maxval=float(np.log(1e-1))))
    return {
        'x_prompt': nrm(ks[0], (BATCH, SEQ, d), 1.0),
        'x_sample': nrm(ks[1], (DEC_BATCH, DEC_SEQ, d), 1.0),
        'c_prompt': nrm(ks[2], (BATCH, d), 1.0),
        'c_sample': nrm(ks[3], (DEC_BATCH, d), 1.0),
        'state_gla': nrm(ks[4], (DEPTH, DEC_BATCH, GLA_HEADS, GLA_DK, GLA_DV), GLA_DK ** -0.5),
        'state_gdn': nrm(ks[5], (DEPTH, DEC_BATCH, GDN_HEADS, GDN_DK, GDN_DV), GDN_DK ** -0.5),
        'state_gdn_conv': nrm(ks[6], (DEPTH, DEC_BATCH, GDN_CONV - 1, GDN_CONV_DIM), 1.0),
        'state_ffn_conv': nrm(ks[7], (DEPTH, DEC_BATCH, FFN_CONV - 1, D_FF), 1.0),
        'w_ada': nrm(ks[8], (DEPTH, d, N_MOD * d), d ** -0.5),
        'b_ada': nrm(ks[9], (DEPTH, N_MOD * d), 0.02),
        'norm1': 1.0 + nrm(ks[10], (DEPTH, d), 0.02),
        'w_in': nrm(ks[11], (DEPTH, d, D_IN), d ** -0.5),
        'gla_wg': nrm(ks[12], (DEPTH, GLA_GATE_RANK, GLA_HEADS * GLA_DK), GLA_GATE_RANK ** -0.5),
        'gla_bg': nrm(ks[13], (DEPTH, GLA_HEADS * GLA_DK), 0.02),
        'gla_norm': 1.0 + nrm(ks[14], (DEPTH, GLA_DV), 0.02),
        'gdn_conv_w': nrm(ks[16], (DEPTH, GDN_CONV, GDN_CONV_DIM), GDN_CONV ** -0.5),
        'gdn_a_log': jnp.log(jax.random.uniform(ks[17], (DEPTH, GDN_HEADS), f32,
                                                minval=1.0, maxval=16.0)),
        'gdn_dt_bias': dt + jnp.log(-jnp.expm1(-dt)),
        'gdn_norm': 1.0 + nrm(ks[18], (DEPTH, GDN_DV), 0.02),
        'w_out': nrm(ks[19], (DEPTH, MIX_WIDTH, d), MIX_WIDTH ** -0.5),
        'norm2': 1.0 + nrm(ks[20], (DEPTH, d), 0.02),
        'w_up': nrm(ks[21], (DEPTH, d, 2 * D_FF), d ** -0.5),
        'ffn_conv_w': nrm(ks[22], (DEPTH, FFN_CONV, D_FF), FFN_CONV ** -0.5),
        'ffn_conv_b': nrm(ks[23], (DEPTH, D_FF), 0.02),
        'w_down': nrm(ks[24], (DEPTH, D_FF, d), D_FF ** -0.5),
        'final_norm': 1.0 + nrm(ks[25], (d,), 0.02),
    }


def reference(x_prompt, x_sample, c_prompt, c_sample, state_gla, state_gdn, state_gdn_conv,
              state_ffn_conv, w_ada, b_ada, norm1, w_in, gla_wg, gla_bg, gla_norm, gdn_conv_w,
              gdn_a_log, gdn_dt_bias, gdn_norm, w_out, norm2, w_up, ffn_conv_w, ffn_conv_b,
              w_down, final_norm):
    params = (w_ada, b_ada, norm1, w_in, gla_wg, gla_bg, gla_norm, gdn_conv_w, gdn_a_log,
              gdn_dt_bias, gdn_norm, w_out, norm2, w_up, ffn_conv_w, ffn_conv_b, w_down,
              final_norm)
    b = x_prompt.shape[0]
    fresh = (jnp.zeros((DEPTH, b, GLA_HEADS, GLA_DK, GLA_DV), jnp.float32),
             jnp.zeros((DEPTH, b, GDN_HEADS, GDN_DK, GDN_DV), jnp.float32),
             jnp.zeros((DEPTH, b, GDN_CONV - 1, GDN_CONV_DIM), x_prompt.dtype),
             jnp.zeros((DEPTH, b, FFN_CONV - 1, D_FF), x_prompt.dtype))
    y_prompt, p_gla, p_gdn, p_conv, p_ffn = trunk(x_prompt, c_prompt, fresh, params, CHUNK)
    y_sample, s_gla, s_gdn, s_conv, s_ffn = trunk(
        x_sample, c_sample, (state_gla, state_gdn, state_gdn_conv, state_ffn_conv), params,
        x_sample.shape[1])
    return (y_prompt, y_sample, p_gla, p_gdn, p_conv, p_ffn, s_gla, s_gdn, s_conv, s_ffn)
```

```cpp
#include <hip/hip_runtime.h>
#include <hip/hip_cooperative_groups.h>
#include <cstdio>
namespace cg = cooperative_groups;

#define LAS __attribute__((address_space(3)))
typedef unsigned short bf16_t;
typedef short bf16x8 __attribute__((ext_vector_type(8)));
typedef float f32x4 __attribute__((ext_vector_type(4)));
typedef unsigned u32x4 __attribute__((ext_vector_type(4)));
typedef unsigned u32x2 __attribute__((ext_vector_type(2)));

constexpr int T_ROWS = 9216, DM = 2048, NPROJ = 7168, DFF = 5632, NUP = 11264, NSEQ = 20, NCHUNK = 144;
constexpr int PC_GLA_Q = 0, PC_GLA_K = 512, PC_GLA_V = 1024, PC_GLA_R = 2048, PC_GDN_Q = 3072, PC_GDN_K = 4096, PC_GDN_V = 5120, PC_GDN_G = 6144;
constexpr int W_IN_LD = 7200;
constexpr size_t OUT_Y = 0, OUT_P_GLA = 18874368, OUT_P_GDN = 19398656, OUT_P_CONV = 19922944, OUT_P_FFN = 19959808,
                 OUT_S_GLA = 20004864, OUT_S_GDN = 22102016, OUT_S_CONV = 24199168, OUT_S_FFN = 24346624, OUT_TOTAL = 24526848;
constexpr size_t MiB = 1u << 20;
constexpr size_t WS_WT_OUT = 0, WS_WT_UP = 8 * MiB, WS_WT_DOWN = 52 * MiB, WS_MIXO = 74 * MiB, WS_PROJ = 110 * MiB, WS_X1 = 110 * MiB, WS_H2 = 182 * MiB,
                 WS_WT_IN = 236 * MiB, WS_H1 = 264 * MiB, WS_OPS = 236 * MiB, WS_ACT = 236 * MiB, WS_SMALL = 358 * MiB;
constexpr size_t WS_MOD = WS_SMALL, WS_PSMALL = WS_SMALL + 1 * MiB, WS_WT_SMALL = WS_PSMALL + 1280 * 1024, WS_GLAST = WS_WT_SMALL + 128 * 1024,
                 WS_HEADG = WS_GLAST + 1 * MiB, WS_HEADV = WS_HEADG + 6553600, WS_TAILG = WS_HEADV + 6553600, WS_END = WS_TAILG + 6553600;
constexpr size_t OPS_UNIT = 73728;
constexpr int LDS_BYTES = 155648;
constexpr float EPSF = 1e-6f;

struct Params;
#define CPARAMS const __attribute__((address_space(4))) Params&
struct Params {
    const float *x_prompt, *x_sample, *c_prompt, *c_sample, *state_gla, *state_gdn, *state_gdn_conv, *state_ffn_conv, *w_ada, *b_ada, *norm1, *w_in, *gla_wg, *gla_bg,
        *gla_norm, *gdn_conv_w, *gdn_a_log, *gdn_dt_bias, *gdn_norm, *w_out, *norm2, *w_up, *ffn_conv_w, *ffn_conv_b, *w_down, *final_norm;
    float* out; unsigned char* ws; int ph_lo, ph_hi;
};

typedef float f32x2v __attribute__((ext_vector_type(2)));
typedef __bf16 bf16x2v __attribute__((ext_vector_type(2)));
__device__ __forceinline__ unsigned cvt_pk_bf16(float lo, float hi) { f32x2v v = {lo, hi}; bf16x2v b = __builtin_convertvector(v, bf16x2v); unsigned r; __builtin_memcpy(&r, &b, 4); return r; }
__device__ __forceinline__ bf16_t f2bf(float f) { return (bf16_t)(cvt_pk_bf16(f, 0.f) & 0xffffu); }
__device__ __forceinline__ float bf2f(bf16_t b) { return __uint_as_float(((unsigned)b) << 16); }
__device__ __forceinline__ float bflo(unsigned u) { return __uint_as_float(u << 16); }
__device__ __forceinline__ float bfhi(unsigned u) { return __uint_as_float(u & 0xffff0000u); }
__device__ __forceinline__ float siluf(float x) { return x / (1.f + __expf(-x)); }
__device__ __forceinline__ int seq_of_row(int r) { return r < 8192 ? (r >> 11) : 4 + ((r - 8192) >> 6); }
__device__ __forceinline__ const float* xrow(CPARAMS p, int r) { return r < 8192 ? p.x_prompt + (size_t)r * DM : p.x_sample + (size_t)(r - 8192) * DM; }
__device__ __forceinline__ f32x4 mfma16(bf16x8 a, bf16x8 b, f32x4 c) { return __builtin_amdgcn_mfma_f32_16x16x32_bf16(a, b, c, 0, 0, 0); }
__device__ __forceinline__ bf16x8 ldfrag(const bf16_t* base, int row, int ld, int k) { return *(const bf16x8*)(base + row * ld + k); }

__device__ __forceinline__ void gemv_unit(CPARAMS p, unsigned char* lds, int u) {
    const int tid = threadIdx.x, w = tid >> 6, lane = tid & 63;
    float* tab = (float*)lds;
    float* red = (float*)(lds + 40960);
    float* mod = (float*)(p.ws + WS_MOD);
    const int col4 = 256 * u + 4 * lane;
    float acc[NSEQ][4];
#pragma unroll
    for (int s = 0; s < NSEQ; ++s) { acc[s][0] = 0.f; acc[s][1] = 0.f; acc[s][2] = 0.f; acc[s][3] = 0.f; }
    for (int sub = 0; sub < 4; ++sub) {
        const int k0 = w * 256 + sub * 64;
        __syncthreads();
#pragma unroll
        for (int s = 0; s < NSEQ; ++s) { const float c = (s < 4) ? p.c_prompt[s * DM + k0 + lane] : p.c_sample[(s - 4) * DM + k0 + lane]; tab[(w * NSEQ + s) * 64 + lane] = siluf(c); }
        __syncthreads();
        for (int k = 0; k < 64; k += 4) {
            float4 wv[4];
#pragma unroll
            for (int i = 0; i < 4; ++i) wv[i] = *(const float4*)(p.w_ada + (size_t)(k0 + k + i) * 12288 + col4);
#pragma unroll
            for (int s = 0; s < NSEQ; ++s) {
                const float4 t = *(const float4*)&tab[(w * NSEQ + s) * 64 + k];
                acc[s][0] += t.x * wv[0].x + t.y * wv[1].x + t.z * wv[2].x + t.w * wv[3].x;
                acc[s][1] += t.x * wv[0].y + t.y * wv[1].y + t.z * wv[2].y + t.w * wv[3].y;
                acc[s][2] += t.x * wv[0].z + t.y * wv[1].z + t.z * wv[2].z + t.w * wv[3].z;
                acc[s][3] += t.x * wv[0].w + t.y * wv[1].w + t.z * wv[2].w + t.w * wv[3].w;
            }
        }
    }
    for (int w2 = 0; w2 < 8; ++w2) {
        if (w == w2) {
#pragma unroll
            for (int s = 0; s < NSEQ; ++s) {
                float4* q = (float4*)&red[s * 256 + 4 * lane];
                float4 v; if (w2 == 0) v = make_float4(0.f, 0.f, 0.f, 0.f); else v = *q;
                v.x += acc[s][0]; v.y += acc[s][1]; v.z += acc[s][2]; v.w += acc[s][3]; *q = v;
            }
        }
        __syncthreads();
    }
    for (int idx = tid; idx < NSEQ * 256; idx += 512) { const int s = idx >> 8, c = idx & 255; mod[s * 12288 + 256 * u + c] = red[idx] + p.b_ada[256 * u + c]; }
    __syncthreads();
}

__device__ __forceinline__ void cvt_tile(unsigned char* lds, const float* __restrict__ src, int ld, int k0, bf16_t* __restrict__ dst, int K, int scol0, bool small) {
    const int tid = threadIdx.x;
    unsigned* Tl = (unsigned*)lds;
    const int c4 = (tid & 15) * 4;
    int scol = scol0 + c4;
    bool valid = true;
    if (small) { valid = c4 < 32; scol = (c4 < 16) ? (3072 + c4) : (7184 + c4 - 16); }
#pragma unroll
    for (int i = 0; i < 2; ++i) {
        const int kp = (tid >> 4) + 32 * i;
        float4 a = make_float4(0.f, 0.f, 0.f, 0.f), b = a;
        if (valid) { a = *(const float4*)(src + (size_t)(k0 + 2 * kp) * ld + scol); b = *(const float4*)(src + (size_t)(k0 + 2 * kp + 1) * ld + scol); }
        Tl[(c4 + 0) * 65 + kp] = cvt_pk_bf16(a.x, b.x); Tl[(c4 + 1) * 65 + kp] = cvt_pk_bf16(a.y, b.y);
        Tl[(c4 + 2) * 65 + kp] = cvt_pk_bf16(a.z, b.z); Tl[(c4 + 3) * 65 + kp] = cvt_pk_bf16(a.w, b.w);
    }
    __syncthreads();
    {
        const int n = tid >> 3, seg = tid & 7;
        u32x4 o0, o1;
        o0.x = Tl[n * 65 + seg * 8 + 0]; o0.y = Tl[n * 65 + seg * 8 + 1]; o0.z = Tl[n * 65 + seg * 8 + 2]; o0.w = Tl[n * 65 + seg * 8 + 3];
        o1.x = Tl[n * 65 + seg * 8 + 4]; o1.y = Tl[n * 65 + seg * 8 + 5]; o1.z = Tl[n * 65 + seg * 8 + 6]; o1.w = Tl[n * 65 + seg * 8 + 7];
        if (!small || n < 32) { u32x4* d = (u32x4*)(dst + (size_t)n * K + k0 + seg * 16); d[0] = o0; d[1] = o1; }
    }
    __syncthreads();
}

constexpr int NCVT_IN = 1792, NCVT_SMALL = 16, NCVT_OUT = 512, NCVT_UP = 2816, NCVT_DOWN = 1408, NCVT = NCVT_IN + NCVT_SMALL + NCVT_OUT + NCVT_UP + NCVT_DOWN;
__device__ __forceinline__ void cvt_unit(CPARAMS p, unsigned char* lds, int j) {
    if (j < NCVT_IN) { const int nt = j >> 4, kt = j & 15; const int n0 = nt * 64; const int sc = n0 < 3072 ? n0 : n0 + 16;
        cvt_tile(lds, p.w_in, W_IN_LD, kt * 128, (bf16_t*)(p.ws + WS_WT_IN) + (size_t)n0 * DM, DM, sc, false); return; }
    j -= NCVT_IN;
    if (j < NCVT_SMALL) { cvt_tile(lds, p.w_in, W_IN_LD, j * 128, (bf16_t*)(p.ws + WS_WT_SMALL), DM, 0, true); return; }
    j -= NCVT_SMALL;
    if (j < NCVT_OUT) { const int nt = j >> 4, kt = j & 15; cvt_tile(lds, p.w_out, DM, kt * 128, (bf16_t*)(p.ws + WS_WT_OUT) + (size_t)(nt * 64) * DM, DM, nt * 64, false); return; }
    j -= NCVT_OUT;
    if (j < NCVT_UP) { const int nt = j >> 4, kt = j & 15; const int pn = nt >> 2, bj = (nt >> 1) & 1, cc0 = (nt & 1) * 64;
        cvt_tile(lds, p.w_up, NUP, kt * 128, (bf16_t*)(p.ws + WS_WT_UP) + (size_t)(nt * 64) * DM, DM, bj * DFF + pn * 128 + cc0, false); return; }
    j -= NCVT_UP;
    { const int nt = j / 44, kt = j % 44; cvt_tile(lds, p.w_down, DM, kt * 128, (bf16_t*)(p.ws + WS_WT_DOWN) + (size_t)(nt * 64) * DFF, DFF, nt * 64, false); }
}

__device__ __forceinline__ void phase_prep(CPARAMS p, unsigned char* lds) {
    const int G = gridDim.x, b = blockIdx.x;
    if (G >= 96) {
        if (b < 48) gemv_unit(p, lds, b);
        else for (int j = b - 48; j < NCVT; j += G - 48) cvt_unit(p, lds, j);
    } else {
        for (int u = b; u < 48; u += G) gemv_unit(p, lds, u);
        for (int j = b; j < NCVT; j += G) cvt_unit(p, lds, j);
    }
}

template <int MODE> __device__ __forceinline__ void norm_phase(CPARAMS p, unsigned char* lds) {
    const int tid = threadIdx.x, w = tid >> 6, lane = tid & 63, fr = lane & 15, fq = lane >> 4;
    float* cA = (float*)lds; float* cB = cA + 2048; float* red = cB + 2048; float* part = red + 128;
    const float* mod = (const float*)(p.ws + WS_MOD);
    bf16x8 bw[2][8];
    if (MODE == 0) {
        const bf16_t* wts = (const bf16_t*)(p.ws + WS_WT_SMALL);
#pragma unroll
        for (int nb = 0; nb < 2; ++nb)
#pragma unroll
            for (int ks = 0; ks < 8; ++ks) bw[nb][ks] = *(const bf16x8*)(wts + (size_t)(16 * nb + fr) * DM + 256 * w + 32 * ks + 8 * fq);
    }
    int cur_s = -1;
    for (int u = blockIdx.x; u < T_ROWS / 16; u += gridDim.x) {
        const int row0 = 16 * u, s = seq_of_row(row0);
        if (s != cur_s) {
            __syncthreads();
            for (int k = tid; k < DM; k += 512) {
                float a, b;
                if (MODE == 0) { a = p.norm1[k] * (1.f + mod[s * 12288 + 2048 + k]); b = mod[s * 12288 + k]; }
                else if (MODE == 1) { a = p.norm2[k] * (1.f + mod[s * 12288 + 8192 + k]); b = mod[s * 12288 + 6144 + k]; }
                else { a = p.final_norm[k]; b = 0.f; }
                cA[k] = a; cB[k] = b;
            }
            cur_s = s;
            __syncthreads();
        }
        const int row = row0 + fr;
        const float* src = (MODE == 0) ? xrow(p, row) : (const float*)(p.ws + WS_X1) + (size_t)row * DM;
        float4 xv[8][2];
        float ss = 0.f;
#pragma unroll
        for (int ks = 0; ks < 8; ++ks) {
            const float4* q = (const float4*)(src + 256 * w + 32 * ks + 8 * fq);
            xv[ks][0] = q[0]; xv[ks][1] = q[1];
            ss += xv[ks][0].x * xv[ks][0].x + xv[ks][0].y * xv[ks][0].y + xv[ks][0].z * xv[ks][0].z + xv[ks][0].w * xv[ks][0].w;
            ss += xv[ks][1].x * xv[ks][1].x + xv[ks][1].y * xv[ks][1].y + xv[ks][1].z * xv[ks][1].z + xv[ks][1].w * xv[ks][1].w;
        }
        ss += __shfl_xor(ss, 16); ss += __shfl_xor(ss, 32);
        if (fq == 0) red[w * 16 + fr] = ss;
        __syncthreads();
        float tot = 0.f;
#pragma unroll
        for (int i = 0; i < 8; ++i) tot += red[i * 16 + fr];
        const float rstd = rsqrtf(tot * (1.f / 2048.f) + EPSF);
        int drow = row;
        if (MODE == 1) { const int tt = row & 255, k8 = tt & 7, l16 = tt >> 3; drow = (row & ~255) + 128 * (k8 >> 2) + 64 * (l16 >> 4) + 16 * (k8 & 3) + (l16 & 15); }
        f32x4 acc0 = {0.f, 0.f, 0.f, 0.f}, acc1 = {0.f, 0.f, 0.f, 0.f};
#pragma unroll
        for (int ks = 0; ks < 8; ++ks) {
            const int k = 256 * w + 32 * ks + 8 * fq;
            const float4 a0 = *(const float4*)&cA[k], a1 = *(const float4*)&cA[k + 4], b0 = *(const float4*)&cB[k], b1 = *(const float4*)&cB[k + 4];
            float4 h0, h1;
            h0.x = xv[ks][0].x * rstd * a0.x + b0.x; h0.y = xv[ks][0].y * rstd * a0.y + b0.y; h0.z = xv[ks][0].z * rstd * a0.z + b0.z; h0.w = xv[ks][0].w * rstd * a0.w + b0.w;
            h1.x = xv[ks][1].x * rstd * a1.x + b1.x; h1.y = xv[ks][1].y * rstd * a1.y + b1.y; h1.z = xv[ks][1].z * rstd * a1.z + b1.z; h1.w = xv[ks][1].w * rstd * a1.w + b1.w;
            if (MODE == 2) { float4* o = (float4*)(p.out + OUT_Y + (size_t)row * DM + k); o[0] = h0; o[1] = h1; }
            else {
                u32x4 pk; pk.x = cvt_pk_bf16(h0.x, h0.y); pk.y = cvt_pk_bf16(h0.z, h0.w); pk.z = cvt_pk_bf16(h1.x, h1.y); pk.w = cvt_pk_bf16(h1.z, h1.w);
                bf16_t* hb = (bf16_t*)(p.ws + (MODE == 0 ? WS_H1 : WS_H2));
                *(u32x4*)(hb + (size_t)drow * DM + k) = pk;
                if (MODE == 0) { bf16x8 af; __builtin_memcpy(&af, &pk, 16); acc0 = mfma16(af, bw[0][ks], acc0); acc1 = mfma16(af, bw[1][ks], acc1); }
            }
        }
        if (MODE == 0) {
#pragma unroll
            for (int e = 0; e < 4; ++e) { part[(w * 16 + 4 * fq + e) * 32 + fr] = acc0[e]; part[(w * 16 + 4 * fq + e) * 32 + 16 + fr] = acc1[e]; }
            __syncthreads();
            const int r = tid >> 5, c = tid & 31; float sum = 0.f;
#pragma unroll
            for (int i = 0; i < 8; ++i) sum += part[(i * 16 + r) * 32 + c];
            ((float*)(p.ws + WS_PSMALL))[(size_t)(row0 + r) * 32 + c] = sum;
        }
        __syncthreads();
    }
}

namespace pg8 {
constexpr int BM = 256, BK = 64, HALF = 128, HTB = HALF * BK * 2, STAGE_BYTES = 8 * HTB, NXCD = 8, WGM = 8;
__device__ __forceinline__ int lds_byte(int r, int c) { const int st = (r >> 4) * 2 + (c >> 5), rr = r & 15, cc = c & 31, ob = rr * 64 + cc * 2; return st * 1024 + (ob ^ (((ob >> 9) & 1) << 5)); }
__device__ __forceinline__ void stage_rc(int b, int& R, int& C) { const int st = b / 1024, sb = b % 1024, swz = sb ^ (((sb >> 9) & 1) << 5); R = (st >> 1) * 16 + swz / 64; C = (st & 1) * 32 + (swz % 64) / 2; }
__device__ __forceinline__ int perm32(int rho) { const int n = rho >> 4, i = rho & 15; return 8 * (i >> 2) + 4 * n + (i & 3); }
struct Unit { int pm, pn; };
struct Gemm { const bf16_t* A; const bf16_t* Bt; int M, N, K; };
struct StaticOrder {
    int nM, nN, nwg, G, c;
    __device__ void init(int M, int N, int G_, int c_) { nM = M / BM; nN = N / BM; nwg = nM * nN; G = G_; c = c_; }
    __device__ bool next(int i, Unit& u) const {
        const long L = (long)i * G + c; if (L >= nwg) return false;
        int wgid = (int)L; { const int q = nwg / NXCD, r = nwg % NXCD, xcd = wgid % NXCD, off = wgid / NXCD; wgid = (xcd < r ? xcd * (q + 1) : r * (q + 1) + (xcd - r) * q) + off; }
        const int nig = WGM * nN, gid = wgid / nig, fm = gid * WGM, gsz = (nM - fm) < WGM ? (nM - fm) : WGM;
        u.pm = fm + ((wgid % nig) % gsz); u.pn = (wgid % nig) / gsz; return true;
    }
};

template <class Epi>
__device__ __forceinline__ void gemm_phase(LAS unsigned char* lds, const Gemm g, const StaticOrder& S, const Epi& E) {
    const int tid = threadIdx.x, wid = __builtin_amdgcn_readfirstlane(tid >> 6), lane = tid & 63, wr = wid >> 2, wc = wid & 3, fr = lane & 15, fq = lane >> 4;
    const int K = g.K, nt = K / BK;
    unsigned voffA[2], voffB[2];
#pragma unroll
    for (int i = 0; i < 2; ++i) { int R, C; stage_rc(tid * 16 + i * 8192, R, C); const int Rb = Epi::PERM ? ((R & ~31) + perm32(R & 31)) : R;
        voffA[i] = (unsigned)(R * K + C) * 2u; voffB[i] = (unsigned)(Rb * K + C) * 2u; }
    const size_t kstep = (size_t)(BK * 2);
    const size_t hstep = (size_t)HALF * K * 2;
    const size_t tstep = 2 * hstep;
    const unsigned ldsw = (unsigned)wid * 1024u;
    const int aoff = lds_byte(wr * 64 + fr, fq * 8), boff = lds_byte(wc * 32 + fr, fq * 8);
#define PG8_SA(b, h) (((b) * 2 + (h)) * HTB)
#define PG8_SB(b, h) ((4 + (b) * 2 + (h)) * HTB)
#define PG8_STAGE(bufoff, gbase, voff) do { _Pragma("unroll") for (int _i = 0; _i < 2; ++_i) \
        __builtin_amdgcn_global_load_lds((const unsigned*)((const char*)(gbase) + (voff)[_i]), (LAS unsigned*)(lds + (bufoff) + ldsw + _i * 8192), 16, 0, 0); } while (0)
#define PG8_LDA(dst, b, h) do { _Pragma("unroll") for (int m = 0; m < 4; ++m) _Pragma("unroll") for (int k = 0; k < 2; ++k) dst[m][k] = *(const LAS bf16x8*)(lds + PG8_SA(b, h) + aoff + m * 2048 + k * 1024); } while (0)
#define PG8_LDB(dst, b, h) do { _Pragma("unroll") for (int n = 0; n < 2; ++n) _Pragma("unroll") for (int k = 0; k < 2; ++k) dst[n][k] = *(const LAS bf16x8*)(lds + PG8_SB(b, h) + boff + n * 2048 + k * 1024); } while (0)
#define PG8_MMA(ai, bj, At, Bt) do { __builtin_amdgcn_s_setprio(1); _Pragma("unroll") for (int m = 0; m < 4; ++m) _Pragma("unroll") for (int n = 0; n < 2; ++n) _Pragma("unroll") for (int k = 0; k < 2; ++k) \
        acc[ai][bj][m][n] = __builtin_amdgcn_mfma_f32_16x16x32_bf16(Bt[n][k], At[m][k], acc[ai][bj][m][n], 0, 0, 0); __builtin_amdgcn_s_setprio(0); } while (0)
#define PG8_WAIT_V(n) asm volatile("s_waitcnt vmcnt(" #n ")" ::: "memory")
#define PG8_WAIT_L(n) asm volatile("s_waitcnt lgkmcnt(" #n ")" ::: "memory")
#define PG8_BAR __builtin_amdgcn_s_barrier()
#define PG8_SCHED __builtin_amdgcn_sched_barrier(0)
    Unit cur, nxt; int ui = 0;
    if (!S.next(0, cur)) return;
    f32x4 acc[2][2][4][2];
#pragma unroll
    for (int a = 0; a < 2; ++a)
#pragma unroll
        for (int b = 0; b < 2; ++b)
#pragma unroll
            for (int m = 0; m < 4; ++m)
#pragma unroll
                for (int n = 0; n < 2; ++n) acc[a][b][m][n] = (f32x4){0.f, 0.f, 0.f, 0.f};
    bf16x8 At[4][2], B0[2][2], B1[2][2];
    const char* cA = (const char*)g.A + (size_t)cur.pm * tstep; const char* cB = (const char*)g.Bt + (size_t)cur.pn * tstep;
    PG8_STAGE(PG8_SB(0, 0), cB, voffB); PG8_STAGE(PG8_SA(0, 0), cA, voffA); PG8_STAGE(PG8_SB(0, 1), cB + hstep, voffB); PG8_STAGE(PG8_SA(0, 1), cA + hstep, voffA);
    if (wr == 1) PG8_BAR;
    PG8_WAIT_V(4); PG8_BAR;
    PG8_STAGE(PG8_SB(1, 0), cB + kstep, voffB); PG8_STAGE(PG8_SA(1, 0), cA + kstep, voffA); PG8_STAGE(PG8_SB(1, 1), cB + hstep + kstep, voffB);
    PG8_WAIT_V(6); PG8_BAR;
    for (;;) {
        const bool has_next = S.next(ui + 1, nxt);
        const char* nA = has_next ? (const char*)g.A + (size_t)nxt.pm * tstep : cA; const char* nB = has_next ? (const char*)g.Bt + (size_t)nxt.pn * tstep : cB;
        for (int t = 0; t < nt; t += 2) {
            const bool last = (t == nt - 2);
            const char* a1 = cA + (size_t)(t + 1) * kstep;
            const char* a2 = last ? nA : cA + (size_t)(t + 2) * kstep; const char* b2 = last ? nB : cB + (size_t)(t + 2) * kstep;
            const char* a3 = a2 + kstep; const char* b3 = b2 + kstep;
            PG8_LDB(B0, 0, 0); PG8_SCHED; PG8_LDA(At, 0, 0); PG8_STAGE(PG8_SA(1, 1), a1 + hstep, voffA);
            PG8_WAIT_L(8); PG8_BAR; PG8_WAIT_L(0); PG8_MMA(0, 0, At, B0); PG8_BAR; PG8_SCHED;
            PG8_LDB(B1, 0, 1); PG8_STAGE(PG8_SB(0, 0), b2, voffB);
            PG8_BAR; PG8_WAIT_L(0); PG8_MMA(0, 1, At, B1); PG8_BAR;
            PG8_LDA(At, 0, 1); PG8_STAGE(PG8_SA(0, 0), a2, voffA);
            PG8_BAR; PG8_WAIT_L(0); PG8_MMA(1, 0, At, B0); PG8_BAR; PG8_SCHED;
            PG8_STAGE(PG8_SB(0, 1), b2 + hstep, voffB);
            PG8_WAIT_V(6); PG8_BAR; PG8_MMA(1, 1, At, B1); PG8_BAR;
            PG8_LDB(B0, 1, 0); PG8_SCHED; PG8_LDA(At, 1, 0); PG8_STAGE(PG8_SA(0, 1), a2 + hstep, voffA);
            PG8_WAIT_L(8); PG8_BAR; PG8_WAIT_L(0); PG8_MMA(0, 0, At, B0); PG8_BAR; PG8_SCHED;
            PG8_LDB(B1, 1, 1); PG8_STAGE(PG8_SB(1, 0), b3, voffB);
            PG8_BAR; PG8_WAIT_L(0); PG8_MMA(0, 1, At, B1); PG8_BAR;
            PG8_LDA(At, 1, 1); PG8_STAGE(PG8_SA(1, 0), a3, voffA);
            PG8_BAR; PG8_WAIT_L(0); PG8_MMA(1, 0, At, B0); PG8_BAR; PG8_SCHED;
            PG8_STAGE(PG8_SB(1, 1), b3 + hstep, voffB);
            PG8_WAIT_V(6); PG8_BAR; PG8_MMA(1, 1, At, B1); PG8_BAR;
        }
        E(acc, cur, wr, wc, fr, fq);
        if (!has_next) break;
#pragma unroll
        for (int a = 0; a < 2; ++a)
#pragma unroll
            for (int b = 0; b < 2; ++b)
#pragma unroll
                for (int m = 0; m < 4; ++m)
#pragma unroll
                    for (int n = 0; n < 2; ++n) acc[a][b][m][n] = (f32x4){0.f, 0.f, 0.f, 0.f};
        cur = nxt; cA = nA; cB = nB; ++ui;
    }
    PG8_WAIT_V(0);
    if (wr == 0) PG8_BAR;
    PG8_BAR;
#undef PG8_SA
#undef PG8_SB
#undef PG8_STAGE
#undef PG8_LDA
#undef PG8_LDB
#undef PG8_MMA
#undef PG8_WAIT_V
#undef PG8_WAIT_L
#undef PG8_BAR
#undef PG8_SCHED
}

struct EpiProj {
    static constexpr bool PERM = true;
    bf16_t* O; int ldc;
    __device__ __forceinline__ void operator()(const f32x4 (&acc)[2][2][4][2], const Unit& u, int wr, int wc, int fr, int fq) const {
        const int row0 = u.pm * BM + wr * 64 + fr, col0 = u.pn * BM + wc * 32 + 8 * fq;
#pragma unroll
        for (int ai = 0; ai < 2; ++ai)
#pragma unroll
            for (int m = 0; m < 4; ++m) { bf16_t* rowp = O + (size_t)(row0 + ai * HALF + m * 16) * ldc + col0;
#pragma unroll
                for (int bj = 0; bj < 2; ++bj) { const f32x4 v0 = acc[ai][bj][m][0], v1 = acc[ai][bj][m][1];
                    u32x4 w; w.x = cvt_pk_bf16(v0[0], v0[1]); w.y = cvt_pk_bf16(v0[2], v0[3]); w.z = cvt_pk_bf16(v1[0], v1[1]); w.w = cvt_pk_bf16(v1[2], v1[3]);
                    *(u32x4*)(rowp + bj * HALF) = w; } }
    }
};
struct EpiResid {
    static constexpr bool PERM = false;
    float* out; const float* resP; const float* resS; const float* gate;
    __device__ __forceinline__ void operator()(const f32x4 (&acc)[2][2][4][2], const Unit& u, int wr, int wc, int fr, int fq) const {
        const int col0 = u.pn * BM + wc * 32 + 4 * fq;
#pragma unroll
        for (int ai = 0; ai < 2; ++ai) {
            const int rbase = u.pm * BM + ai * HALF + wr * 64;
            const int s = seq_of_row(rbase);
            f32x4 gv[2][2];
#pragma unroll
            for (int bj = 0; bj < 2; ++bj)
#pragma unroll
                for (int n = 0; n < 2; ++n) gv[bj][n] = *(const f32x4*)(gate + (size_t)s * 12288 + col0 + bj * HALF + n * 16);
#pragma unroll
            for (int m = 0; m < 4; ++m) {
                const int r = rbase + m * 16 + fr;
                const float* rp = (resS == nullptr) ? resP + (size_t)r * DM : (r < 8192 ? resP + (size_t)r * DM : resS + (size_t)(r - 8192) * DM);
                float* op = out + (size_t)r * DM;
#pragma unroll
                for (int bj = 0; bj < 2; ++bj)
#pragma unroll
                    for (int n = 0; n < 2; ++n) { const int c = col0 + bj * HALF + n * 16; const f32x4 rv = *(const f32x4*)(rp + c); *(f32x4*)(op + c) = rv + gv[bj][n] * acc[ai][bj][m][n]; }
            }
        }
    }
};
struct EpiUp {
    static constexpr bool PERM = true;
    bf16_t* act; const float* cw; const float* cb; float* headg; float* headv; float* tailg;
    __device__ __forceinline__ void operator()(const f32x4 (&acc)[2][2][4][2], const Unit& u, int wr, int wc, int fr, int fq) const {
        const int tok0 = u.pm * BM + (wr * 16 + fr) * 8;
        const int sc = tok0 >> 6;
        const bool head = (fr & 7) == 0, tail = (fr & 7) == 7;
#pragma unroll
        for (int n = 0; n < 2; ++n) {
            const int ch0 = u.pn * 128 + wc * 32 + 8 * fq + 4 * n;
            const f32x4 w0 = *(const f32x4*)(cw + ch0), w1 = *(const f32x4*)(cw + DFF + ch0), w2 = *(const f32x4*)(cw + 2 * DFF + ch0), bb = *(const f32x4*)(cb + ch0);
            float o[8][4];
#pragma unroll
            for (int j = 0; j < 4; ++j) {
                float g[8], v[8];
#pragma unroll
                for (int k = 0; k < 8; ++k) { g[k] = acc[k >> 2][0][k & 3][n][j]; v[k] = acc[k >> 2][1][k & 3][n][j]; }
                const float p6 = __shfl_up(g[6], 1, 16), p7 = __shfl_up(g[7], 1, 16);
                o[0][j] = siluf(w0[j] * p6 + w1[j] * p7 + w2[j] * g[0] + bb[j]) * v[0];
                o[1][j] = siluf(w0[j] * p7 + w1[j] * g[0] + w2[j] * g[1] + bb[j]) * v[1];
#pragma unroll
                for (int k = 2; k < 8; ++k) o[k][j] = siluf(w0[j] * g[k - 2] + w1[j] * g[k - 1] + w2[j] * g[k] + bb[j]) * v[k];
            }
#pragma unroll
            for (int k = 0; k < 8; ++k) {
                if (k < 2 && head) continue;
                u32x2 w; w.x = cvt_pk_bf16(o[k][0], o[k][1]); w.y = cvt_pk_bf16(o[k][2], o[k][3]);
                *(u32x2*)(act + (size_t)(tok0 + k) * DFF + ch0) = w;
            }
            if (head) {
#pragma unroll
                for (int k = 0; k < 2; ++k) {
                    *(f32x4*)(headg + ((size_t)sc * 2 + k) * DFF + ch0) = (f32x4){acc[0][0][k][n][0], acc[0][0][k][n][1], acc[0][0][k][n][2], acc[0][0][k][n][3]};
                    *(f32x4*)(headv + ((size_t)sc * 2 + k) * DFF + ch0) = (f32x4){acc[0][1][k][n][0], acc[0][1][k][n][1], acc[0][1][k][n][2], acc[0][1][k][n][3]};
                }
            }
            if (tail) {
#pragma unroll
                for (int k = 0; k < 2; ++k)
                    *(f32x4*)(tailg + ((size_t)sc * 2 + k) * DFF + ch0) = (f32x4){acc[1][0][2 + k][n][0], acc[1][0][2 + k][n][1], acc[1][0][2 + k][n][2], acc[1][0][2 + k][n][3]};
            }
        }
    }
};
}

__device__ __forceinline__ float softplusf(float x) { return x > 20.f ? x : log1pf(__expf(x)); }

__device__ __forceinline__ void gdn_prep(CPARAMS p, unsigned char* lds, int sc, int hd) {
    const int tid = threadIdx.x, w = tid >> 6, lane = tid & 63, fr = lane & 15, fq = lane >> 4;
    float* qf = (float*)lds; float* kf = qf + 64 * 129; float* vf = kf + 64 * 129;
    bf16_t* qn = (bf16_t*)(lds + 99072); bf16_t* kn = qn + 64 * 136;
    float* sm = (float*)(lds + 133888); float* beta = sm; float* Gc = sm + 64; float* rq = sm + 128; float* rk = sm + 192; float* gt = sm + 256;
    float* Am = qf;
    const bf16_t* proj = (const bf16_t*)(p.ws + WS_PROJ);
    const float* psm = (const float*)(p.ws + WS_PSMALL);
    const int row0 = sc * 64;
    const bool sample = sc >= 128, first = sample || ((sc & 31) == 0), lastc = sample || ((sc & 31) == 31);
    const int s = sample ? 4 + (sc - 128) : (sc >> 5);
    unsigned char* ops = p.ws + WS_OPS + (size_t)(sc * 12 + 4 + hd) * OPS_UNIT;
    bf16_t* o_wvT = (bf16_t*)ops; bf16_t* o_wk = (bf16_t*)(ops + 16384); bf16_t* o_attn = (bf16_t*)(ops + 32768); bf16_t* o_qg = (bf16_t*)(ops + 40960); bf16_t* o_kgT = (bf16_t*)(ops + 57344);
    float* outc = p.out + (s < 4 ? OUT_P_CONV + (size_t)s * 9216 : OUT_S_CONV + (size_t)(s - 4) * 9216);
    {
        const int d = tid & 127, tg = tid >> 7, t0 = tg * 16;
#pragma unroll
        for (int mat = 0; mat < 3; ++mat) {
            const int pc = PC_GDN_Q + mat * 1024 + hd * 128 + d, cc = mat * 1024 + hd * 128 + d;
            const float w0 = p.gdn_conv_w[cc], w1 = p.gdn_conv_w[3072 + cc], w2 = p.gdn_conv_w[2 * 3072 + cc], w3 = p.gdn_conv_w[3 * 3072 + cc];
            float h[3];
#pragma unroll
            for (int j = 1; j <= 3; ++j) {
                const int tt = t0 - j; float val;
                if (tt >= 0 || !first) val = bf2f(proj[(size_t)(row0 + tt) * NPROJ + pc]);
                else if (sample) val = p.state_gdn_conv[(size_t)(s - 4) * 9216 + (3 + tt) * 3072 + cc];
                else val = 0.f;
                h[j - 1] = val;
            }
            float xm1 = h[0], xm2 = h[1], xm3 = h[2];
            float* dst = mat == 0 ? qf : (mat == 1 ? kf : vf);
#pragma unroll
            for (int i = 0; i < 16; ++i) {
                const float x0 = bf2f(proj[(size_t)(row0 + t0 + i) * NPROJ + pc]);
                const float y = w0 * xm3 + w1 * xm2 + w2 * xm1 + w3 * x0;
                dst[(t0 + i) * 129 + d] = siluf(y);
                if (lastc && (t0 + i) >= 61) outc[(t0 + i - 61) * 3072 + cc] = x0;
                xm3 = xm2; xm2 = xm1; xm1 = x0;
            }
        }
    }
    __syncthreads();
    {
        const int t = tid >> 3, part = tid & 7; float sq = 0.f, sk = 0.f;
#pragma unroll
        for (int j = 0; j < 16; ++j) { const float a = qf[t * 129 + part * 16 + j], b = kf[t * 129 + part * 16 + j]; sq += a * a; sk += b * b; }
        sq += __shfl_xor(sq, 1); sq += __shfl_xor(sq, 2); sq += __shfl_xor(sq, 4);
        sk += __shfl_xor(sk, 1); sk += __shfl_xor(sk, 2); sk += __shfl_xor(sk, 4);
        if (part == 0) { rq[t] = rsqrtf(sq + EPSF) * 0.08838834764831845f; rk[t] = rsqrtf(sk + EPSF); }
        if (tid < 64) {
            const float* ps = psm + (size_t)(row0 + tid) * 32;
            beta[tid] = 1.f / (1.f + __expf(-ps[16 + hd]));
            gt[tid] = -__expf(p.gdn_a_log[hd]) * softplusf(ps[24 + hd] + p.gdn_dt_bias[hd]);
        }
    }
    __syncthreads();
    if (tid == 0) { float c = 0.f; for (int t = 0; t < 64; ++t) { c += gt[t]; Gc[t] = c; } }
    __syncthreads();
    for (int idx = tid; idx < 64 * 128; idx += 512) {
        const int t = idx >> 7, d = idx & 127;
        const float q = qf[t * 129 + d] * rq[t], k = kf[t * 129 + d] * rk[t];
        qn[t * 136 + d] = f2bf(q); kn[t * 136 + d] = f2bf(k); kf[t * 129 + d] = k;
    }
    __syncthreads();
    for (int b = w; b < 32; b += 8) {
        const int which = b >> 4, blk = b & 15, mi = blk >> 2, nj = blk & 3;
        const int i = 16 * mi + fr, j0 = 16 * nj + 4 * fq;
        if (nj > mi) { if (which) *(u32x2*)(o_attn + i * 64 + j0) = (u32x2){0u, 0u}; continue; }
        f32x4 D = {0.f, 0.f, 0.f, 0.f};
        const bf16_t* Z = which ? qn : kn;
#pragma unroll
        for (int ks = 0; ks < 4; ++ks) D = mfma16(ldfrag(kn, 16 * nj + fr, 136, ks * 32 + fq * 8), ldfrag(Z, 16 * mi + fr, 136, ks * 32 + fq * 8), D);
        float r[4];
#pragma unroll
        for (int e = 0; e < 4; ++e) {
            const int j = j0 + e; const float dec = __expf(Gc[i] - Gc[j]);
            if (which) r[e] = (j <= i) ? D[e] * dec : 0.f; else r[e] = (j < i) ? D[e] * dec * beta[i] : 0.f;
        }
        if (which) { u32x2 pk; pk.x = cvt_pk_bf16(r[0], r[1]); pk.y = cvt_pk_bf16(r[2], r[3]); *(u32x2*)(o_attn + i * 64 + j0) = pk; }
        else *(f32x4*)(Am + i * 64 + j0) = (f32x4){r[0], r[1], r[2], r[3]};
    }
    {
        const float Gl = Gc[63];
        for (int idx = tid; idx < 1024; idx += 512) {
            const int t = idx >> 4, d8 = (idx & 15) * 8; const float eg = __expf(Gc[t]);
            float v[8];
#pragma unroll
            for (int j = 0; j < 8; ++j) v[j] = bf2f(qn[t * 136 + d8 + j]) * eg;
            u32x4 pk; pk.x = cvt_pk_bf16(v[0], v[1]); pk.y = cvt_pk_bf16(v[2], v[3]); pk.z = cvt_pk_bf16(v[4], v[5]); pk.w = cvt_pk_bf16(v[6], v[7]);
            *(u32x4*)(o_qg + t * 128 + d8) = pk;
        }
        for (int idx = tid; idx < 1024; idx += 512) {
            const int d = idx >> 3, t8 = (idx & 7) * 8;
            float v[8];
#pragma unroll
            for (int j = 0; j < 8; ++j) v[j] = bf2f(kn[(t8 + j) * 136 + d]) * __expf(Gl - Gc[t8 + j]);
            u32x4 pk; pk.x = cvt_pk_bf16(v[0], v[1]); pk.y = cvt_pk_bf16(v[2], v[3]); pk.z = cvt_pk_bf16(v[4], v[5]); pk.w = cvt_pk_bf16(v[6], v[7]);
            *(u32x4*)(o_kgT + d * 64 + t8) = pk;
        }
        if (tid == 0) ((float*)(p.ws + WS_GLAST))[(size_t)(sc * 12 + 4 + hd) * 128] = __expf(Gl);
    }
    __syncthreads();
    if (tid < 256) {
        const int c = tid;
        float* col = (c < 128) ? (vf + c) : (kf + (c - 128));
        for (int i = 0; i < 64; ++i) {
            float r = col[i * 129] * ((c < 128) ? beta[i] : beta[i] * __expf(Gc[i]));
            const float* arow = Am + i * 64;
            int j = 0;
            for (; j + 4 <= i; j += 4) {
                const float4 a = *(const float4*)(arow + j);
                r -= a.x * col[j * 129]; r -= a.y * col[(j + 1) * 129]; r -= a.z * col[(j + 2) * 129]; r -= a.w * col[(j + 3) * 129];
            }
            for (; j < i; ++j) r -= arow[j] * col[j * 129];
            col[i * 129] = r;
        }
    }
    __syncthreads();
    for (int idx = tid; idx < 1024; idx += 512) {
        const int dv = idx >> 3, t8 = (idx & 7) * 8; float v[8];
#pragma unroll
        for (int j = 0; j < 8; ++j) v[j] = vf[(t8 + j) * 129 + dv];
        u32x4 pk; pk.x = cvt_pk_bf16(v[0], v[1]); pk.y = cvt_pk_bf16(v[2], v[3]); pk.z = cvt_pk_bf16(v[4], v[5]); pk.w = cvt_pk_bf16(v[6], v[7]);
        *(u32x4*)(o_wvT + dv * 64 + t8) = pk;
    }
    for (int idx = tid; idx < 1024; idx += 512) {
        const int t = idx >> 4, d8 = (idx & 15) * 8; float v[8];
#pragma unroll
        for (int j = 0; j < 8; ++j) v[j] = kf[t * 129 + d8 + j];
        u32x4 pk; pk.x = cvt_pk_bf16(v[0], v[1]); pk.y = cvt_pk_bf16(v[2], v[3]); pk.z = cvt_pk_bf16(v[4], v[5]); pk.w = cvt_pk_bf16(v[6], v[7]);
        *(u32x4*)(o_wk + t * 128 + d8) = pk;
    }
    __syncthreads();
}

__device__ __forceinline__ void gla_prep(CPARAMS p, unsigned char* lds, int sc, int h) {
    const int tid = threadIdx.x, w = tid >> 6, lane = tid & 63, fr = lane & 15, fq = lane >> 4;
    bf16_t* kraw = (bf16_t*)lds; bf16_t* qraw = (bf16_t*)(lds + 17408); float* Gm = (float*)(lds + 34816);
    bf16_t* qgl = (bf16_t*)(lds + 67840); bf16_t* kdl = (bf16_t*)(lds + 85248); float* alr = (float*)(lds + 102656); float* gsum = (float*)(lds + 106752);
    bf16_t* vl = (bf16_t*)(lds + 108800);
    const bf16_t* proj = (const bf16_t*)(p.ws + WS_PROJ);
    const float* psm = (const float*)(p.ws + WS_PSMALL);
    const int row0 = sc * 64;
    unsigned char* ops = p.ws + WS_OPS + (size_t)(sc * 12 + h) * OPS_UNIT;
    bf16_t* o_vT = (bf16_t*)ops; bf16_t* o_attn = (bf16_t*)(ops + 32768); bf16_t* o_qg = (bf16_t*)(ops + 40960); bf16_t* o_kgT = (bf16_t*)(ops + 57344);
#pragma unroll
    for (int i = 0; i < 2; ++i) { const int idx = tid + 512 * i, t = idx >> 4, seg = idx & 15;
        *(u32x4*)(qraw + t * 136 + seg * 8) = *(const u32x4*)(proj + (size_t)(row0 + t) * NPROJ + PC_GLA_Q + h * 128 + seg * 8);
        *(u32x4*)(kraw + t * 136 + seg * 8) = *(const u32x4*)(proj + (size_t)(row0 + t) * NPROJ + PC_GLA_K + h * 128 + seg * 8); }
#pragma unroll
    for (int i = 0; i < 4; ++i) { const int idx = tid + 512 * i, t = idx >> 5, seg = idx & 31;
        *(u32x4*)(vl + t * 264 + seg * 8) = *(const u32x4*)(proj + (size_t)(row0 + t) * NPROJ + PC_GLA_V + h * 256 + seg * 8); }
    if (tid < 256) { const int t = tid >> 2, q4 = (tid & 3) * 4; *(float4*)(alr + t * 16 + q4) = *(const float4*)(psm + (size_t)(row0 + t) * 32 + q4); }
    __syncthreads();
    const int d = tid & 127, tg = tid >> 7;
    {
        float wg[16];
#pragma unroll
        for (int r = 0; r < 16; ++r) wg[r] = p.gla_wg[r * 512 + h * 128 + d];
        const float bg = p.gla_bg[h * 128 + d];
        float run = 0.f;
#pragma unroll
        for (int i = 0; i < 16; ++i) {
            const int t = tg * 16 + i; float z = bg;
#pragma unroll
            for (int r = 0; r < 16; ++r) z += alr[t * 16 + r] * wg[r];
            const float la = (fminf(z, 0.f) - log1pf(__expf(-fabsf(z)))) * (1.f / 16.f);
            run += la; Gm[t * 129 + d] = run;
        }
        gsum[tg * 128 + d] = run;
    }
    __syncthreads();
    {
        float off = 0.f, Gl = 0.f;
#pragma unroll
        for (int g = 0; g < 4; ++g) { const float v = gsum[g * 128 + d]; if (g < tg) off += v; Gl += v; }
#pragma unroll
        for (int i = 0; i < 16; ++i) {
            const int t = tg * 16 + i; const float G = Gm[t * 129 + d] + off;
            const float q = bf2f(qraw[t * 136 + d]) * 0.08838834764831845f, k = bf2f(kraw[t * 136 + d]);
            qgl[t * 136 + d] = f2bf(q * __expf(G)); kdl[t * 136 + d] = f2bf(k * __expf(-G)); kraw[t * 136 + d] = f2bf(k * __expf(Gl - G));
        }
        if (tg == 0) ((float*)(p.ws + WS_GLAST))[(size_t)(sc * 12 + h) * 128 + d] = __expf(Gl);
    }
    __syncthreads();
#if !defined(GLA_DBG) || GLA_DBG >= 2
#endif
{
    for (int idx = tid; idx < 1024; idx += 512) { const int t = idx >> 4, seg = idx & 15; *(u32x4*)(o_qg + t * 128 + seg * 8) = *(const u32x4*)(qgl + t * 136 + seg * 8); }
#if !defined(GLA_DBG) || GLA_DBG >= 3
    for (int idx = tid; idx < 1024; idx += 512) {
        const int dd = idx >> 3, t8 = (idx & 7) * 8; unsigned short v[8];
#pragma unroll
        for (int j = 0; j < 8; ++j) v[j] = kraw[(t8 + j) * 136 + dd];
        u32x4 pk; pk.x = v[0] | ((unsigned)v[1] << 16); pk.y = v[2] | ((unsigned)v[3] << 16); pk.z = v[4] | ((unsigned)v[5] << 16); pk.w = v[6] | ((unsigned)v[7] << 16);
        *(u32x4*)(o_kgT + dd * 64 + t8) = pk;
    }
    for (int idx = tid; idx < 2048; idx += 512) {
        const int dv = idx >> 3, t8 = (idx & 7) * 8; unsigned short v[8];
#pragma unroll
        for (int j = 0; j < 8; ++j) v[j] = vl[(t8 + j) * 264 + dv];
        u32x4 pk; pk.x = v[0] | ((unsigned)v[1] << 16); pk.y = v[2] | ((unsigned)v[3] << 16); pk.z = v[4] | ((unsigned)v[5] << 16); pk.w = v[6] | ((unsigned)v[7] << 16);
        *(u32x4*)(o_vT + dv * 64 + t8) = pk;
    }
    for (int b = w; b < 16; b += 8) {
        const int mi = b >> 2, nj = b & 3; const int i = 16 * mi + fr, j0 = 16 * nj + 4 * fq;
        if (nj > mi) { *(u32x2*)(o_attn + i * 64 + j0) = (u32x2){0u, 0u}; continue; }
        f32x4 D = {0.f, 0.f, 0.f, 0.f};
#pragma unroll
        for (int ks = 0; ks < 4; ++ks) D = mfma16(ldfrag(kdl, 16 * nj + fr, 136, ks * 32 + fq * 8), ldfrag(qgl, 16 * mi + fr, 136, ks * 32 + fq * 8), D);
        float r[4];
#pragma unroll
        for (int e = 0; e < 4; ++e) r[e] = (j0 + e <= i) ? D[e] : 0.f;
        u32x2 pk; pk.x = cvt_pk_bf16(r[0], r[1]); pk.y = cvt_pk_bf16(r[2], r[3]); *(u32x2*)(o_attn + i * 64 + j0) = pk;
    }
#endif
}
    __syncthreads();
}

__device__ __forceinline__ void phase_chunk_prep(CPARAMS p, unsigned char* lds) {
    for (int u = blockIdx.x; u < NCHUNK * 12; u += gridDim.x) {
        const int sc = u / 12, hh = u % 12;
#ifndef NO_GLA_PREP
        if (hh < 4) gla_prep(p, lds, sc, hh);
#endif
#ifndef NO_GDN_PREP
        if (hh >= 4) gdn_prep(p, lds, sc, hh - 4);
#endif
    }
}

__device__ __forceinline__ void gdn_chain(CPARAMS p, unsigned char* lds, int s, int hd) {
    const int tid = threadIdx.x, w = tid >> 6, lane = tid & 63, fr = lane & 15, fq = lane >> 4;
    bf16_t* Wk = (bf16_t*)lds; bf16_t* qg = (bf16_t*)(lds + 17408); bf16_t* attn = (bf16_t*)(lds + 34816); bf16_t* kgT = (bf16_t*)(lds + 44032);
    bf16_t* WvT = (bf16_t*)(lds + 62464); bf16_t* ST = (bf16_t*)(lds + 80896); bf16_t* uT = (bf16_t*)(lds + 115712); float* red = (float*)(lds + 134144);
    const int nch = s < 4 ? 32 : 1, sc0 = s < 4 ? s * 32 : 128 + (s - 4);
    const bf16_t* proj = (const bf16_t*)(p.ws + WS_PROJ);
    bf16_t* mixo = (bf16_t*)(p.ws + WS_MIXO);
    const float* glast = (const float*)(p.ws + WS_GLAST);
    const int dvr = 16 * w + fr;
    f32x4 sacc[8];
#pragma unroll
    for (int nb = 0; nb < 8; ++nb) {
        if (s >= 4) {
            const float* st = p.state_gdn + (size_t)((s - 4) * 8 + hd) * 16384 + (size_t)(16 * nb + 4 * fq) * 128 + dvr;
            asm volatile("" : "+v"(st));
#pragma unroll
            for (int e = 0; e < 4; ++e) sacc[nb][e] = st[e * 128];
        } else sacc[nb] = (f32x4){0.f, 0.f, 0.f, 0.f};
        u32x2 pk; pk.x = cvt_pk_bf16(sacc[nb][0], sacc[nb][1]); pk.y = cvt_pk_bf16(sacc[nb][2], sacc[nb][3]);
        *(u32x2*)(ST + dvr * 136 + 16 * nb + 4 * fq) = pk;
    }
    u32x4 pf[9];
    {
        const u32x4* src = (const u32x4*)(p.ws + WS_OPS + (size_t)(sc0 * 12 + 4 + hd) * OPS_UNIT);
#pragma unroll
        for (int i = 0; i < 9; ++i) pf[i] = src[tid + 512 * i];
    }
    for (int c = 0; c < nch; ++c) {
        const int sc = sc0 + c; int row0 = sc * 64; asm volatile("" : "+v"(row0));
#pragma unroll
        for (int i = 0; i < 9; ++i) {
            const int q = tid + 512 * i;
            bf16_t* dst;
            if (i < 2) dst = WvT + (q >> 3) * 72 + (q & 7) * 8;
            else if (i < 4) { const int q2 = q - 1024; dst = Wk + (q2 >> 4) * 136 + (q2 & 15) * 8; }
            else if (i < 5) { const int q2 = q - 2048; dst = attn + (q2 >> 3) * 72 + (q2 & 7) * 8; }
            else if (i < 7) { const int q2 = q - 2560; dst = qg + (q2 >> 4) * 136 + (q2 & 15) * 8; }
            else { const int q2 = q - 3584; dst = kgT + (q2 >> 3) * 72 + (q2 & 7) * 8; }
            *(u32x4*)dst = pf[i];
        }
        const float decay = glast[(size_t)(sc * 12 + 4 + hd) * 128];
        __syncthreads();
        if (c + 1 < nch) {
            const u32x4* src = (const u32x4*)(p.ws + WS_OPS + (size_t)((sc + 1) * 12 + 4 + hd) * OPS_UNIT);
#pragma unroll
            for (int i = 0; i < 9; ++i) pf[i] = src[tid + 512 * i];
        }
        bf16x8 stf[4];
#pragma unroll
        for (int ks = 0; ks < 4; ++ks) stf[ks] = ldfrag(ST, dvr, 136, ks * 32 + fq * 8);
#pragma unroll
        for (int tb = 0; tb < 4; ++tb) {
            f32x4 D = {0.f, 0.f, 0.f, 0.f};
#pragma unroll
            for (int ks = 0; ks < 4; ++ks) D = mfma16(ldfrag(Wk, 16 * tb + fr, 136, ks * 32 + fq * 8), stf[ks], D);
            const u32x2 wv = *(const u32x2*)(WvT + dvr * 72 + 16 * tb + 4 * fq);
            u32x2 pk; pk.x = cvt_pk_bf16(bflo(wv.x) - D[0], bfhi(wv.x) - D[1]); pk.y = cvt_pk_bf16(bflo(wv.y) - D[2], bfhi(wv.y) - D[3]);
            *(u32x2*)(uT + dvr * 72 + 16 * tb + 4 * fq) = pk;
        }
        asm volatile("s_waitcnt lgkmcnt(0)" ::: "memory");
        bf16x8 utf[2];
#pragma unroll
        for (int ks = 0; ks < 2; ++ks) utf[ks] = ldfrag(uT, dvr, 72, ks * 32 + fq * 8);
        f32x4 o[4];
#pragma unroll
        for (int tb = 0; tb < 4; ++tb) {
            f32x4 D = {0.f, 0.f, 0.f, 0.f};
#pragma unroll
            for (int ks = 0; ks < 4; ++ks) D = mfma16(stf[ks], ldfrag(qg, 16 * tb + fr, 136, ks * 32 + fq * 8), D);
#pragma unroll
            for (int ks = 0; ks < 2; ++ks) D = mfma16(utf[ks], ldfrag(attn, 16 * tb + fr, 72, ks * 32 + fq * 8), D);
            o[tb] = D;
            float ss = D[0] * D[0] + D[1] * D[1] + D[2] * D[2] + D[3] * D[3];
            ss += __shfl_xor(ss, 16); ss += __shfl_xor(ss, 32);
            if (fq == 0) red[w * 64 + 16 * tb + fr] = ss;
        }
#pragma unroll
        for (int nb = 0; nb < 8; ++nb) {
            f32x4 a = sacc[nb] * decay;
#pragma unroll
            for (int ks = 0; ks < 2; ++ks) a = mfma16(ldfrag(kgT, 16 * nb + fr, 72, ks * 32 + fq * 8), utf[ks], a);
            sacc[nb] = a;
            u32x2 pk; pk.x = cvt_pk_bf16(a[0], a[1]); pk.y = cvt_pk_bf16(a[2], a[3]);
            *(u32x2*)(ST + dvr * 136 + 16 * nb + 4 * fq) = pk;
        }
        __syncthreads();
        {
            const int dv0 = 16 * w + 4 * fq;
            const f32x4 nrm = *(const f32x4*)(p.gdn_norm + dv0);
#pragma unroll
            for (int tb = 0; tb < 4; ++tb) {
                const int t = 16 * tb + fr; float tot = 0.f;
#pragma unroll
                for (int i = 0; i < 8; ++i) tot += red[i * 64 + t];
                const float rstd = rsqrtf(tot * (1.f / 128.f) + EPSF);
                const size_t row = (size_t)(row0 + t);
                const u32x2 gt = *(const u32x2*)(proj + row * NPROJ + PC_GDN_G + hd * 128 + dv0);
                const float g0 = siluf(bflo(gt.x)), g1 = siluf(bfhi(gt.x)), g2 = siluf(bflo(gt.y)), g3 = siluf(bfhi(gt.y));
                u32x2 pk; pk.x = cvt_pk_bf16(o[tb][0] * rstd * nrm[0] * g0, o[tb][1] * rstd * nrm[1] * g1); pk.y = cvt_pk_bf16(o[tb][2] * rstd * nrm[2] * g2, o[tb][3] * rstd * nrm[3] * g3);
                *(u32x2*)(mixo + row * DM + 1024 + hd * 128 + dv0) = pk;
            }
        }
        __syncthreads();
    }
    float* so = p.out + (s < 4 ? OUT_P_GDN + (size_t)(s * 8 + hd) * 16384 : OUT_S_GDN + (size_t)((s - 4) * 8 + hd) * 16384);
#pragma unroll
    for (int nb = 0; nb < 8; ++nb)
        { float* q = so + (size_t)(16 * nb + 4 * fq) * 128 + dvr; asm volatile("" : "+v"(q));
#pragma unroll
          for (int e = 0; e < 4; ++e) q[e * 128] = sacc[nb][e]; }
}

__device__ __forceinline__ void gla_chain(CPARAMS p, unsigned char* lds, int s, int h) {
    const int tid = threadIdx.x, w = tid >> 6, lane = tid & 63, fr = lane & 15, fq = lane >> 4;
    bf16_t* qg = (bf16_t*)lds; bf16_t* attn = (bf16_t*)(lds + 17408); bf16_t* kgT = (bf16_t*)(lds + 26624); bf16_t* vT = (bf16_t*)(lds + 45056);
    bf16_t* ST = (bf16_t*)(lds + 81920); float* red = (float*)(lds + 151552); float* gl = (float*)(lds + 153600);
    const int nch = s < 4 ? 32 : 1, sc0 = s < 4 ? s * 32 : 128 + (s - 4);
    const bf16_t* proj = (const bf16_t*)(p.ws + WS_PROJ);
    bf16_t* mixo = (bf16_t*)(p.ws + WS_MIXO);
    const float* glast = (const float*)(p.ws + WS_GLAST);
    f32x4 sacc[2][8];
#pragma unroll
    for (int db = 0; db < 2; ++db) {
        const int dvr = 32 * w + 16 * db + fr;
#pragma unroll
        for (int nb = 0; nb < 8; ++nb) {
            if (s >= 4) {
                const float* st = p.state_gla + (size_t)((s - 4) * 4 + h) * 32768 + (size_t)(16 * nb + 4 * fq) * 256 + dvr;
                asm volatile("" : "+v"(st));
#pragma unroll
                for (int e = 0; e < 4; ++e) sacc[db][nb][e] = st[e * 256];
            } else sacc[db][nb] = (f32x4){0.f, 0.f, 0.f, 0.f};
            u32x2 pk; pk.x = cvt_pk_bf16(sacc[db][nb][0], sacc[db][nb][1]); pk.y = cvt_pk_bf16(sacc[db][nb][2], sacc[db][nb][3]);
            *(u32x2*)(ST + dvr * 136 + 16 * nb + 4 * fq) = pk;
        }
    }
    u32x4 pf[9]; float glp = 0.f;
    {
        const u32x4* src = (const u32x4*)(p.ws + WS_OPS + (size_t)(sc0 * 12 + h) * OPS_UNIT);
#pragma unroll
        for (int i = 0; i < 9; ++i) pf[i] = src[tid + 512 * i];
        if (tid < 128) glp = glast[(size_t)(sc0 * 12 + h) * 128 + tid];
    }
    for (int c = 0; c < nch; ++c) {
        const int sc = sc0 + c; int row0 = sc * 64; asm volatile("" : "+v"(row0));
#pragma unroll
        for (int i = 0; i < 9; ++i) {
            const int q = tid + 512 * i;
            bf16_t* dst;
            if (i < 4) dst = vT + (q >> 3) * 72 + (q & 7) * 8;
            else if (i < 5) { const int q2 = q - 2048; dst = attn + (q2 >> 3) * 72 + (q2 & 7) * 8; }
            else if (i < 7) { const int q2 = q - 2560; dst = qg + (q2 >> 4) * 136 + (q2 & 15) * 8; }
            else { const int q2 = q - 3584; dst = kgT + (q2 >> 3) * 72 + (q2 & 7) * 8; }
            *(u32x4*)dst = pf[i];
        }
        if (tid < 128) gl[tid] = glp;
        __syncthreads();
        f32x4 o[2][4];
        float ssum[4] = {0.f, 0.f, 0.f, 0.f};
        bf16x8 vtf[2][2];
#pragma unroll
        for (int db = 0; db < 2; ++db) {
            asm volatile("" ::: "memory");
            const int dvr = 32 * w + 16 * db + fr;
            bf16x8 stf[4];
#pragma unroll
            for (int ks = 0; ks < 4; ++ks) stf[ks] = ldfrag(ST, dvr, 136, ks * 32 + fq * 8);
#pragma unroll
            for (int ks = 0; ks < 2; ++ks) vtf[db][ks] = ldfrag(vT, dvr, 72, ks * 32 + fq * 8);
#pragma unroll
            for (int tb = 0; tb < 4; ++tb) {
                f32x4 D = {0.f, 0.f, 0.f, 0.f};
#pragma unroll
                for (int ks = 0; ks < 4; ++ks) D = mfma16(stf[ks], ldfrag(qg, 16 * tb + fr, 136, ks * 32 + fq * 8), D);
#pragma unroll
                for (int ks = 0; ks < 2; ++ks) D = mfma16(vtf[db][ks], ldfrag(attn, 16 * tb + fr, 72, ks * 32 + fq * 8), D);
                o[db][tb] = D;
                ssum[tb] += D[0] * D[0] + D[1] * D[1] + D[2] * D[2] + D[3] * D[3];
            }
        }
#pragma unroll
        for (int tb = 0; tb < 4; ++tb) { float ss = ssum[tb]; ss += __shfl_xor(ss, 16); ss += __shfl_xor(ss, 32); if (fq == 0) red[w * 64 + 16 * tb + fr] = ss; }
        asm volatile("" ::: "memory");
        if (c + 1 < nch) {
            const u32x4* src = (const u32x4*)(p.ws + WS_OPS + (size_t)((sc + 1) * 12 + h) * OPS_UNIT);
#pragma unroll
            for (int i = 0; i < 9; ++i) pf[i] = src[tid + 512 * i];
            if (tid < 128) glp = glast[(size_t)((sc + 1) * 12 + h) * 128 + tid];
        }
#pragma unroll
        for (int nb = 0; nb < 8; ++nb) {
            const f32x4 dec = *(const f32x4*)(gl + 16 * nb + 4 * fq);
            bf16x8 kf0 = ldfrag(kgT, 16 * nb + fr, 72, fq * 8), kf1 = ldfrag(kgT, 16 * nb + fr, 72, 32 + fq * 8);
#pragma unroll
            for (int db = 0; db < 2; ++db) {
                const int dvr = 32 * w + 16 * db + fr;
                f32x4 a = sacc[db][nb] * dec;
                a = mfma16(kf0, vtf[db][0], a); a = mfma16(kf1, vtf[db][1], a);
                sacc[db][nb] = a;
                u32x2 pk; pk.x = cvt_pk_bf16(a[0], a[1]); pk.y = cvt_pk_bf16(a[2], a[3]);
                *(u32x2*)(ST + dvr * 136 + 16 * nb + 4 * fq) = pk;
            }
        }
        __syncthreads();
#pragma unroll
        for (int tb = 0; tb < 4; ++tb) {
            const int t = 16 * tb + fr; float tot = 0.f;
#pragma unroll
            for (int i = 0; i < 8; ++i) tot += red[i * 64 + t];
            const float rstd = rsqrtf(tot * (1.f / 256.f) + EPSF);
            const size_t row = (size_t)(row0 + t);
#pragma unroll
            for (int db = 0; db < 2; ++db) {
                const int dv0 = 32 * w + 16 * db + 4 * fq;
                const f32x4 nrm = *(const f32x4*)(p.gla_norm + dv0);
                const u32x2 gt = *(const u32x2*)(proj + row * NPROJ + PC_GLA_R + h * 256 + dv0);
                const float g0 = siluf(bflo(gt.x)), g1 = siluf(bfhi(gt.x)), g2 = siluf(bflo(gt.y)), g3 = siluf(bfhi(gt.y));
                const f32x4 ov = o[db][tb];
                u32x2 pk; pk.x = cvt_pk_bf16(ov[0] * rstd * nrm[0] * g0, ov[1] * rstd * nrm[1] * g1); pk.y = cvt_pk_bf16(ov[2] * rstd * nrm[2] * g2, ov[3] * rstd * nrm[3] * g3);
                *(u32x2*)(mixo + row * DM + h * 256 + dv0) = pk;
            }
        }
        __syncthreads();
    }
    float* so = p.out + (s < 4 ? OUT_P_GLA + (size_t)(s * 4 + h) * 32768 : OUT_S_GLA + (size_t)((s - 4) * 4 + h) * 32768);
#pragma unroll
    for (int db = 0; db < 2; ++db)
#pragma unroll
        for (int nb = 0; nb < 8; ++nb)
            { float* q = so + (size_t)(16 * nb + 4 * fq) * 256 + 32 * w + 16 * db + fr; asm volatile("" : "+v"(q));
#pragma unroll
              for (int e = 0; e < 4; ++e) q[e * 256] = sacc[db][nb][e]; }
}

__device__ __forceinline__ void phase_recur(CPARAMS p, unsigned char* lds) {
    for (int u = blockIdx.x; u < NSEQ * 12; u += gridDim.x) {
        const int s = u / 12, hh = u % 12;
#ifndef NO_GLA_CHAIN
        if (hh < 4) gla_chain(p, lds, s, hh);
#endif
#ifndef NO_GDN_CHAIN
        if (hh >= 4) gdn_chain(p, lds, s, hh - 4);
#endif
        __syncthreads();
    }
}

__device__ __forceinline__ void phase_halo(CPARAMS p) {
    const float* headg = (const float*)(p.ws + WS_HEADG); const float* headv = (const float*)(p.ws + WS_HEADV); const float* tailg = (const float*)(p.ws + WS_TAILG);
    bf16_t* act = (bf16_t*)(p.ws + WS_ACT);
    for (int idx = blockIdx.x * 512 + threadIdx.x; idx < NCHUNK * DFF; idx += gridDim.x * 512) {
        const int sc = idx / DFF, ch = idx % DFF;
        const bool sample = sc >= 128, first = sample || ((sc & 31) == 0), lastc = sample || ((sc & 31) == 31);
        const int s = sample ? 4 + (sc - 128) : (sc >> 5);
        float gm2, gm1;
        if (!first) { gm2 = tailg[((size_t)(sc - 1) * 2 + 0) * DFF + ch]; gm1 = tailg[((size_t)(sc - 1) * 2 + 1) * DFF + ch]; }
        else if (sample) { gm2 = p.state_ffn_conv[(size_t)(s - 4) * 11264 + ch]; gm1 = p.state_ffn_conv[(size_t)(s - 4) * 11264 + DFF + ch]; }
        else { gm2 = 0.f; gm1 = 0.f; }
        const float g0 = headg[((size_t)sc * 2) * DFF + ch], g1 = headg[((size_t)sc * 2 + 1) * DFF + ch];
        const float v0 = headv[((size_t)sc * 2) * DFF + ch], v1 = headv[((size_t)sc * 2 + 1) * DFF + ch];
        const float w0 = p.ffn_conv_w[ch], w1 = p.ffn_conv_w[DFF + ch], w2 = p.ffn_conv_w[2 * DFF + ch], bb = p.ffn_conv_b[ch];
        act[(size_t)(sc * 64) * DFF + ch] = f2bf(siluf(w0 * gm2 + w1 * gm1 + w2 * g0 + bb) * v0);
        act[(size_t)(sc * 64 + 1) * DFF + ch] = f2bf(siluf(w0 * gm1 + w1 * g0 + w2 * g1 + bb) * v1);
        if (lastc) {
            float* of = p.out + (s < 4 ? OUT_P_FFN + (size_t)s * 11264 : OUT_S_FFN + (size_t)(s - 4) * 11264);
            of[ch] = tailg[((size_t)sc * 2) * DFF + ch]; of[DFF + ch] = tailg[((size_t)sc * 2 + 1) * DFF + ch];
        }
    }
}

constexpr int NPHASE = 11;
#ifdef ONLY_PHASE
#define PH_EN(n) ((n) == ONLY_PHASE)
#else
#define PH_EN(n) true
#endif
__global__ void __launch_bounds__(512) fwd_megakernel(Params p_) {
    typedef const __attribute__((address_space(4))) Params* KP;
    KP pp0 = (KP)__builtin_amdgcn_kernarg_segment_ptr();
    const int ph_lo_ = p_.ph_lo, ph_hi_ = p_.ph_hi;
#define p (*({ KP q_ = pp0; asm volatile("" : "+s"(q_)); q_; }))
    extern __shared__ __attribute__((aligned(16))) unsigned char shm[];
    cg::grid_group grid = cg::this_grid();
    const bool multi = (ph_hi_ - ph_lo_) > 1;
#define PH_ON(n) (PH_EN(n) && ph_lo_ <= (n) && (n) < ph_hi_)
#define PH_SYNC(n) do { if (multi && (n) + 1 < ph_hi_ && (n) >= ph_lo_) { __threadfence(); grid.sync(); } } while (0)
    if (PH_ON(0)) phase_prep(p, shm);
    PH_SYNC(0);
    if (PH_ON(1)) norm_phase<0>(p, shm);
    PH_SYNC(1);
    if (PH_ON(2)) { pg8::Gemm g{(const bf16_t*)(p.ws + WS_H1), (const bf16_t*)(p.ws + WS_WT_IN), T_ROWS, NPROJ, DM};
        pg8::StaticOrder S; S.init(g.M, g.N, (int)gridDim.x, (int)blockIdx.x);
        pg8::EpiProj E{(bf16_t*)(p.ws + WS_PROJ), NPROJ};
        pg8::gemm_phase((LAS unsigned char*)shm, g, S, E); }
    PH_SYNC(2);
    if (PH_ON(3)) phase_chunk_prep(p, shm);
    PH_SYNC(3);
    if (PH_ON(4)) phase_recur(p, shm);
    PH_SYNC(4);
    if (PH_ON(5)) { pg8::Gemm g{(const bf16_t*)(p.ws + WS_MIXO), (const bf16_t*)(p.ws + WS_WT_OUT), T_ROWS, DM, DM};
        pg8::StaticOrder S; S.init(g.M, g.N, (int)gridDim.x, (int)blockIdx.x);
        pg8::EpiResid E{(float*)(p.ws + WS_X1), p.x_prompt, p.x_sample, (const float*)(p.ws + WS_MOD) + 4096};
        pg8::gemm_phase((LAS unsigned char*)shm, g, S, E); }
    PH_SYNC(5);
    if (PH_ON(6)) norm_phase<1>(p, shm);
    PH_SYNC(6);
    if (PH_ON(7)) { pg8::Gemm g{(const bf16_t*)(p.ws + WS_H2), (const bf16_t*)(p.ws + WS_WT_UP), T_ROWS, NUP, DM};
        pg8::StaticOrder S; S.init(g.M, g.N, (int)gridDim.x, (int)blockIdx.x);
        pg8::EpiUp E{(bf16_t*)(p.ws + WS_ACT), p.ffn_conv_w, p.ffn_conv_b, (float*)(p.ws + WS_HEADG), (float*)(p.ws + WS_HEADV), (float*)(p.ws + WS_TAILG)};
        pg8::gemm_phase((LAS unsigned char*)shm, g, S, E); }
    PH_SYNC(7);
    if (PH_ON(8)) phase_halo(p);
    PH_SYNC(8);
    if (PH_ON(9)) { pg8::Gemm g{(const bf16_t*)(p.ws + WS_ACT), (const bf16_t*)(p.ws + WS_WT_DOWN), T_ROWS, DM, DFF};
        pg8::StaticOrder S; S.init(g.M, g.N, (int)gridDim.x, (int)blockIdx.x);
        pg8::EpiResid E{(float*)(p.ws + WS_X1), (const float*)(p.ws + WS_X1), nullptr, (const float*)(p.ws + WS_MOD) + 10240};
        pg8::gemm_phase((LAS unsigned char*)shm, g, S, E); }
    PH_SYNC(9);
    if (PH_ON(10)) norm_phase<2>(p, shm);
#undef p
}


#ifdef DBG_STOP
__global__ void dbg_digest(const unsigned short* ws16, size_t L, float* out, size_t n) {
    for (size_t i = (size_t)blockIdx.x * blockDim.x + threadIdx.x; i < n; i += (size_t)gridDim.x * blockDim.x) {
        unsigned sum = 0; for (size_t j = i; j < L; j += n) sum += ws16[j];
        out[i] = (float)sum;
    }
}
#endif
#ifndef MK_MULTI_LAUNCH
#define MK_MULTI_LAUNCH 0
#endif

extern "C" void kernel_launch(void* const* d_in, const int* in_sizes, int n_in, void* d_out, int out_size, void* d_ws, size_t ws_size, hipStream_t stream) {
    static int grid_blocks = 0;
    if (grid_blocks == 0) {
        if (n_in != 26 || (size_t)out_size != OUT_TOTAL || ws_size < WS_END) {
            fprintf(stderr, "kernel_launch: unexpected shapes: n_in %d out %d ws %zu (need %zu); nothing launched\n", n_in, out_size, ws_size, (size_t)WS_END); grid_blocks = -1; return; }
        int dev = 0, cus = 0, per_cu = 0;
        hipGetDevice(&dev);
        hipDeviceGetAttribute(&cus, hipDeviceAttributeMultiprocessorCount, dev);
        if (hipFuncSetAttribute((const void*)fwd_megakernel, hipFuncAttributeMaxDynamicSharedMemorySize, LDS_BYTES) != hipSuccess) { fprintf(stderr, "kernel_launch: hipFuncSetAttribute failed\n"); grid_blocks = -1; return; }
        if (hipOccupancyMaxActiveBlocksPerMultiprocessor(&per_cu, (const void*)fwd_megakernel, 512, LDS_BYTES) != hipSuccess || per_cu < 1) { fprintf(stderr, "kernel_launch: occupancy query failed (%d)\n", per_cu); grid_blocks = -1; return; }
        grid_blocks = cus * per_cu;
    }
    if (grid_blocks < 0) return;
    Params p{};
    const float** pp = (const float**)&p;
    for (int i = 0; i < 26; ++i) pp[i] = (const float*)d_in[i];
    p.out = (float*)d_out; p.ws = (unsigned char*)d_ws;
#if MK_MULTI_LAUNCH
#ifdef DBG_STOP
    for (int ph = 0; ph <= DBG_STOP; ++ph) { p.ph_lo = ph; p.ph_hi = ph + 1; hipLaunchKernelGGL(fwd_megakernel, dim3(grid_blocks), dim3(512), LDS_BYTES, stream, p); }
    hipLaunchKernelGGL(dbg_digest, dim3(2048), dim3(256), 0, stream, (const unsigned short*)d_ws, (size_t)(WS_END / 2), (float*)d_out, (size_t)OUT_TOTAL);
#else
    for (int ph = 0; ph < NPHASE; ++ph) { p.ph_lo = ph; p.ph_hi = ph + 1; hipLaunchKernelGGL(fwd_megakernel, dim3(grid_blocks), dim3(512), LDS_BYTES, stream, p); }
#endif
#else
    p.ph_lo = 0; p.ph_hi = NPHASE;
    void* args[] = {&p};
    hipError_t e = hipLaunchCooperativeKernel((void*)fwd_megakernel, dim3(grid_blocks), dim3(512), args, LDS_BYTES, stream);
    if (e != hipSuccess) fprintf(stderr, "cooperative launch failed: %s (grid %d)\n", hipGetErrorString(e), grid_blocks);
#endif
}
```

```cpp
#include <hip/hip_runtime.h>
#include <hip/hip_cooperative_groups.h>
#include <cstdio>
namespace cg = cooperative_groups;

#define LAS __attribute__((address_space(3)))
typedef unsigned short bf16_t;
typedef short bf16x8 __attribute__((ext_vector_type(8)));
typedef float f32x4 __attribute__((ext_vector_type(4)));
typedef unsigned u32x4 __attribute__((ext_vector_type(4)));
typedef unsigned u32x2 __attribute__((ext_vector_type(2)));

constexpr int T_ROWS = 9216, DM = 2048, NPROJ = 7168, DFF = 5632, NUP = 11264, NSEQ = 20, NCHUNK = 144;
constexpr int PC_GLA_Q = 0, PC_GLA_K = 512, PC_GLA_V = 1024, PC_GLA_R = 2048, PC_GDN_Q = 3072, PC_GDN_K = 4096, PC_GDN_V = 5120, PC_GDN_G = 6144;
constexpr int W_IN_LD = 7200;
constexpr size_t OUT_Y = 0, OUT_P_GLA = 18874368, OUT_P_GDN = 19398656, OUT_P_CONV = 19922944, OUT_P_FFN = 19959808,
                 OUT_S_GLA = 20004864, OUT_S_GDN = 22102016, OUT_S_CONV = 24199168, OUT_S_FFN = 24346624, OUT_TOTAL = 24526848;
constexpr size_t MiB = 1u << 20;
constexpr size_t WS_WT_OUT = 0, WS_WT_UP = 8 * MiB, WS_WT_DOWN = 52 * MiB, WS_MIXO = 74 * MiB, WS_PROJ = 110 * MiB, WS_X1 = 110 * MiB, WS_H2 = 182 * MiB,
                 WS_WT_IN = 236 * MiB, WS_H1 = 264 * MiB, WS_OPS = 236 * MiB, WS_ACT = 236 * MiB, WS_SMALL = 358 * MiB;
constexpr size_t WS_MOD = WS_SMALL, WS_PSMALL = WS_SMALL + 1 * MiB, WS_WT_SMALL = WS_PSMALL + 1280 * 1024, WS_GLAST = WS_WT_SMALL + 128 * 1024,
                 WS_HEADG = WS_GLAST + 1 * MiB, WS_HEADV = WS_HEADG + 6553600, WS_TAILG = WS_HEADV + 6553600, WS_END = WS_TAILG + 6553600;
constexpr size_t OPS_UNIT = 73728;
constexpr int LDS_BYTES = 155648;
constexpr float EPSF = 1e-6f;

struct Params;
#define CPARAMS const __attribute__((address_space(4))) Params&
struct Params {
    const float *x_prompt, *x_sample, *c_prompt, *c_sample, *state_gla, *state_gdn, *state_gdn_conv, *state_ffn_conv, *w_ada, *b_ada, *norm1, *w_in, *gla_wg, *gla_bg,
        *gla_norm, *gdn_conv_w, *gdn_a_log, *gdn_dt_bias, *gdn_norm, *w_out, *norm2, *w_up, *ffn_conv_w, *ffn_conv_b, *w_down, *final_norm;
    float* out; unsigned char* ws; int ph_lo, ph_hi;
};

typedef float f32x2v __attribute__((ext_vector_type(2)));
typedef __bf16 bf16x2v __attribute__((ext_vector_type(2)));
__device__ __forceinline__ unsigned cvt_pk_bf16(float lo, float hi) { f32x2v v = {lo, hi}; bf16x2v b = __builtin_convertvector(v, bf16x2v); unsigned r; __builtin_memcpy(&r, &b, 4); return r; }
__device__ __forceinline__ bf16_t f2bf(float f) { return (bf16_t)(cvt_pk_bf16(f, 0.f) & 0xffffu); }
__device__ __forceinline__ float bf2f(bf16_t b) { return __uint_as_float(((unsigned)b) << 16); }
__device__ __forceinline__ float bflo(unsigned u) { return __uint_as_float(u << 16); }
__device__ __forceinline__ float bfhi(unsigned u) { return __uint_as_float(u & 0xffff0000u); }
__device__ __forceinline__ float siluf(float x) { return x / (1.f + __expf(-x)); }
__device__ __forceinline__ int seq_of_row(int r) { return r < 8192 ? (r >> 11) : 4 + ((r - 8192) >> 6); }
__device__ __forceinline__ const float* xrow(CPARAMS p, int r) { return r < 8192 ? p.x_prompt + (size_t)r * DM : p.x_sample + (size_t)(r - 8192) * DM; }
__device__ __forceinline__ f32x4 mfma16(bf16x8 a, bf16x8 b, f32x4 c) { return __builtin_amdgcn_mfma_f32_16x16x32_bf16(a, b, c, 0, 0, 0); }
__device__ __forceinline__ bf16x8 ldfrag(const bf16_t* base, int row, int ld, int k) { return *(const bf16x8*)(base + row * ld + k); }

__device__ __forceinline__ void gemv_unit(CPARAMS p, unsigned char* lds, int u) {
    const int tid = threadIdx.x, w = tid >> 6, lane = tid & 63;
    float* tab = (float*)lds;
    float* red = (float*)(lds + 40960);
    float* mod = (float*)(p.ws + WS_MOD);
    const int col4 = 256 * u + 4 * lane;
    float acc[NSEQ][4];
#pragma unroll
    for (int s = 0; s < NSEQ; ++s) { acc[s][0] = 0.f; acc[s][1] = 0.f; acc[s][2] = 0.f; acc[s][3] = 0.f; }
    for (int sub = 0; sub < 4; ++sub) {
        const int k0 = w * 256 + sub * 64;
        __syncthreads();
#pragma unroll
        for (int s = 0; s < NSEQ; ++s) { const float c = (s < 4) ? p.c_prompt[s * DM + k0 + lane] : p.c_sample[(s - 4) * DM + k0 + lane]; tab[(w * NSEQ + s) * 64 + lane] = siluf(c); }
        __syncthreads();
        for (int k = 0; k < 64; k += 4) {
            float4 wv[4];
#pragma unroll
            for (int i = 0; i < 4; ++i) wv[i] = *(const float4*)(p.w_ada + (size_t)(k0 + k + i) * 12288 + col4);
#pragma unroll
            for (int s = 0; s < NSEQ; ++s) {
                const float4 t = *(const float4*)&tab[(w * NSEQ + s) * 64 + k];
                acc[s][0] += t.x * wv[0].x + t.y * wv[1].x + t.z * wv[2].x + t.w * wv[3].x;
                acc[s][1] += t.x * wv[0].y + t.y * wv[1].y + t.z * wv[2].y + t.w * wv[3].y;
                acc[s][2] += t.x * wv[0].z + t.y * wv[1].z + t.z * wv[2].z + t.w * wv[3].z;
                acc[s][3] += t.x * wv[0].w + t.y * wv[1].w + t.z * wv[2].w + t.w * wv[3].w;
            }
        }
    }
    for (int w2 = 0; w2 < 8; ++w2) {
        if (w == w2) {
#pragma unroll
            for (int s = 0; s < NSEQ; ++s) {
                float4* q = (float4*)&red[s * 256 + 4 * lane];
                float4 v; if (w2 == 0) v = make_float4(0.f, 0.f, 0.f, 0.f); else v = *q;
                v.x += acc[s][0]; v.y += acc[s][1]; v.z += acc[s][2]; v.w += acc[s][3]; *q = v;
            }
        }
        __syncthreads();
    }
    for (int idx = tid; idx < NSEQ * 256; idx += 512) { const int s = idx >> 8, c = idx & 255; mod[s * 12288 + 256 * u + c] = red[idx] + p.b_ada[256 * u + c]; }
    __syncthreads();
}

__device__ __forceinline__ void cvt_tile(unsigned char* lds, const float* __restrict__ src, int ld, int k0, bf16_t* __restrict__ dst, int K, int scol0, bool small) {
    const int tid = threadIdx.x;
    unsigned* Tl = (unsigned*)lds;
    const int c4 = (tid & 15) * 4;
    int scol = scol0 + c4;
    bool valid = true;
    if (small) { valid = c4 < 32; scol = (c4 < 16) ? (3072 + c4) : (7184 + c4 - 16); }
#pragma unroll
    for (int i = 0; i < 2; ++i) {
        const int kp = (tid >> 4) + 32 * i;
        float4 a = make_float4(0.f, 0.f, 0.f, 0.f), b = a;
        if (valid) { a = *(const float4*)(src + (size_t)(k0 + 2 * kp) * ld + scol); b = *(const float4*)(src + (size_t)(k0 + 2 * kp + 1) * ld + scol); }
        Tl[(c4 + 0) * 65 + kp] = cvt_pk_bf16(a.x, b.x); Tl[(c4 + 1) * 65 + kp] = cvt_pk_bf16(a.y, b.y);
        Tl[(c4 + 2) * 65 + kp] = cvt_pk_bf16(a.z, b.z); Tl[(c4 + 3) * 65 + kp] = cvt_pk_bf16(a.w, b.w);
    }
    __syncthreads();
    {
        const int n = tid >> 3, seg = tid & 7;
        u32x4 o0, o1;
        o0.x = Tl[n * 65 + seg * 8 + 0]; o0.y = Tl[n * 65 + seg * 8 + 1]; o0.z = Tl[n * 65 + seg * 8 + 2]; o0.w = Tl[n * 65 + seg * 8 + 3];
        o1.x = Tl[n * 65 + seg * 8 + 4]; o1.y = Tl[n * 65 + seg * 8 + 5]; o1.z = Tl[n * 65 + seg * 8 + 6]; o1.w = Tl[n * 65 + seg * 8 + 7];
        if (!small || n < 32) { u32x4* d = (u32x4*)(dst + (size_t)n * K + k0 + seg * 16); d[0] = o0; d[1] = o1; }
    }
    __syncthreads();
}

constexpr int NCVT_IN = 1792, NCVT_SMALL = 16, NCVT_OUT = 512, NCVT_UP = 2816, NCVT_DOWN = 1408, NCVT = NCVT_IN + NCVT_SMALL + NCVT_OUT + NCVT_UP + NCVT_DOWN;
__device__ __forceinline__ void cvt_unit(CPARAMS p, unsigned char* lds, int j) {
    if (j < NCVT_IN) { const int nt = j >> 4, kt = j & 15; const int n0 = nt * 64; const int sc = n0 < 3072 ? n0 : n0 + 16;
        cvt_tile(lds, p.w_in, W_IN_LD, kt * 128, (bf16_t*)(p.ws + WS_WT_IN) + (size_t)n0 * DM, DM, sc, false); return; }
    j -= NCVT_IN;
    if (j < NCVT_SMALL) { cvt_tile(lds, p.w_in, W_IN_LD, j * 128, (bf16_t*)(p.ws + WS_WT_SMALL), DM, 0, true); return; }
    j -= NCVT_SMALL;
    if (j < NCVT_OUT) { const int nt = j >> 4, kt = j & 15; cvt_tile(lds, p.w_out, DM, kt * 128, (bf16_t*)(p.ws + WS_WT_OUT) + (size_t)(nt * 64) * DM, DM, nt * 64, false); return; }
    j -= NCVT_OUT;
    if (j < NCVT_UP) { const int nt = j >> 4, kt = j & 15; const int pn = nt >> 2, bj = (nt >> 1) & 1, cc0 = (nt & 1) * 64;
        cvt_tile(lds, p.w_up, NUP, kt * 128, (bf16_t*)(p.ws + WS_WT_UP) + (size_t)(nt * 64) * DM, DM, bj * DFF + pn * 128 + cc0, false); return; }
    j -= NCVT_UP;
    { const int nt = j / 44, kt = j % 44; cvt_tile(lds, p.w_down, DM, kt * 128, (bf16_t*)(p.ws + WS_WT_DOWN) + (size_t)(nt * 64) * DFF, DFF, nt * 64, false); }
}

__device__ __forceinline__ void phase_prep(CPARAMS p, unsigned char* lds) {
    const int G = gridDim.x, b = blockIdx.x;
    if (G >= 96) {
        if (b < 48) gemv_unit(p, lds, b);
        else for (int j = b - 48; j < NCVT; j += G - 48) cvt_unit(p, lds, j);
    } else {
        for (int u = b; u < 48; u += G) gemv_unit(p, lds, u);
        for (int j = b; j < NCVT; j += G) cvt_unit(p, lds, j);
    }
}

template <int MODE> __device__ __forceinline__ void norm_phase(CPARAMS p, unsigned char* lds) {
    const int tid = threadIdx.x, w = tid >> 6, lane = tid & 63, fr = lane & 15, fq = lane >> 4;
    float* cA = (float*)lds; float* cB = cA + 2048; float* red = cB + 2048; float* part = red + 128;
    const float* mod = (const float*)(p.ws + WS_MOD);
    bf16x8 bw[2][8];
    if (MODE == 0) {
        const bf16_t* wts = (const bf16_t*)(p.ws + WS_WT_SMALL);
#pragma unroll
        for (int nb = 0; nb < 2; ++nb)
#pragma unroll
            for (int ks = 0; ks < 8; ++ks) bw[nb][ks] = *(const bf16x8*)(wts + (size_t)(16 * nb + fr) * DM + 256 * w + 32 * ks + 8 * fq);
    }
    int cur_s = -1;
    for (int u = blockIdx.x; u < T_ROWS / 16; u += gridDim.x) {
        const int row0 = 16 * u, s = seq_of_row(row0);
        if (s != cur_s) {
            __syncthreads();
            for (int k = tid; k < DM; k += 512) {
                float a, b;
                if (MODE == 0) { a = p.norm1[k] * (1.f + mod[s * 12288 + 2048 + k]); b = mod[s * 12288 + k]; }
                else if (MODE == 1) { a = p.norm2[k] * (1.f + mod[s * 12288 + 8192 + k]); b = mod[s * 12288 + 6144 + k]; }
                else { a = p.final_norm[k]; b = 0.f; }
                cA[k] = a; cB[k] = b;
            }
            cur_s = s;
            __syncthreads();
        }
        const int row = row0 + fr;
        const float* src = (MODE == 0) ? xrow(p, row) : (const float*)(p.ws + WS_X1) + (size_t)row * DM;
        float4 xv[8][2];
        float ss = 0.f;
#pragma unroll
        for (int ks = 0; ks < 8; ++ks) {
            const float4* q = (const float4*)(src + 256 * w + 32 * ks + 8 * fq);
            xv[ks][0] = q[0]; xv[ks][1] = q[1];
            ss += xv[ks][0].x * xv[ks][0].x + xv[ks][0].y * xv[ks][0].y + xv[ks][0].z * xv[ks][0].z + xv[ks][0].w * xv[ks][0].w;
            ss += xv[ks][1].x * xv[ks][1].x + xv[ks][1].y * xv[ks][1].y + xv[ks][1].z * xv[ks][1].z + xv[ks][1].w * xv[ks][1].w;
        }
        ss += __shfl_xor(ss, 16); ss += __shfl_xor(ss, 32);
        if (fq == 0) red[w * 16 + fr] = ss;
        __syncthreads();
        float tot = 0.f;
#pragma unroll
        for (int i = 0; i < 8; ++i) tot += red[i * 16 + fr];
        const float rstd = rsqrtf(tot * (1.f / 2048.f) + EPSF);
        int drow = row;
        if (MODE == 1) { const int tt = row & 255, k8 = tt & 7, l16 = tt >> 3; drow = (row & ~255) + 128 * (k8 >> 2) + 64 * (l16 >> 4) + 16 * (k8 & 3) + (l16 & 15); }
        f32x4 acc0 = {0.f, 0.f, 0.f, 0.f}, acc1 = {0.f, 0.f, 0.f, 0.f};
#pragma unroll
        for (int ks = 0; ks < 8; ++ks) {
            const int k = 256 * w + 32 * ks + 8 * fq;
            const float4 a0 = *(const float4*)&cA[k], a1 = *(const float4*)&cA[k + 4], b0 = *(const float4*)&cB[k], b1 = *(const float4*)&cB[k + 4];
            float4 h0, h1;
            h0.x = xv[ks][0].x * rstd * a0.x + b0.x; h0.y = xv[ks][0].y * rstd * a0.y + b0.y; h0.z = xv[ks][0].z * rstd * a0.z + b0.z; h0.w = xv[ks][0].w * rstd * a0.w + b0.w;
            h1.x = xv[ks][1].x * rstd * a1.x + b1.x; h1.y = xv[ks][1].y * rstd * a1.y + b1.y; h1.z = xv[ks][1].z * rstd * a1.z + b1.z; h1.w = xv[ks][1].w * rstd * a1.w + b1.w;
            if (MODE == 2) { float4* o = (float4*)(p.out + OUT_Y + (size_t)row * DM + k); o[0] = h0; o[1] = h1; }
            else {
                u32x4 pk; pk.x = cvt_pk_bf16(h0.x, h0.y); pk.y = cvt_pk_bf16(h0.z, h0.w); pk.z = cvt_pk_bf16(h1.x, h1.y); pk.w = cvt_pk_bf16(h1.z, h1.w);
                bf16_t* hb = (bf16_t*)(p.ws + (MODE == 0 ? WS_H1 : WS_H2));
                *(u32x4*)(hb + (size_t)drow * DM + k) = pk;
                if (MODE == 0) { bf16x8 af; __builtin_memcpy(&af, &pk, 16); acc0 = mfma16(af, bw[0][ks], acc0); acc1 = mfma16(af, bw[1][ks], acc1); }
            }
        }
        if (MODE == 0) {
#pragma unroll
            for (int e = 0; e < 4; ++e) { part[(w * 16 + 4 * fq + e) * 32 + fr] = acc0[e]; part[(w * 16 + 4 * fq + e) * 32 + 16 + fr] = acc1[e]; }
            __syncthreads();
            const int r = tid >> 5, c = tid & 31; float sum = 0.f;
#pragma unroll
            for (int i = 0; i < 8; ++i) sum += part[(i * 16 + r) * 32 + c];
            ((float*)(p.ws + WS_PSMALL))[(size_t)(row0 + r) * 32 + c] = sum;
        }
        __syncthreads();
    }
}

namespace pg8 {
constexpr int BM = 256, BK = 64, HALF = 128, HTB = HALF * BK * 2, STAGE_BYTES = 8 * HTB, NXCD = 8, WGM = 8;
__device__ __forceinline__ int lds_byte(int r, int c) { const int st = (r >> 4) * 2 + (c >> 5), rr = r & 15, cc = c & 31, ob = rr * 64 + cc * 2; return st * 1024 + (ob ^ (((ob >> 9) & 1) << 5)); }
__device__ __forceinline__ void stage_rc(int b, int& R, int& C) { const int st = b / 1024, sb = b % 1024, swz = sb ^ (((sb >> 9) & 1) << 5); R = (st >> 1) * 16 + swz / 64; C = (st & 1) * 32 + (swz % 64) / 2; }
__device__ __forceinline__ int perm32(int rho) { const int n = rho >> 4, i = rho & 15; return 8 * (i >> 2) + 4 * n + (i & 3); }
struct Unit { int pm, pn; };
struct Gemm { const bf16_t* A; const bf16_t* Bt; int M, N, K; };
struct StaticOrder {
    int nM, nN, nwg, G, c;
    __device__ void init(int M, int N, int G_, int c_) { nM = M / BM; nN = N / BM; nwg = nM * nN; G = G_; c = c_; }
    __device__ bool next(int i, Unit& u) const {
        const long L = (long)i * G + c; if (L >= nwg) return false;
        int wgid = (int)L; { const int q = nwg / NXCD, r = nwg % NXCD, xcd = wgid % NXCD, off = wgid / NXCD; wgid = (xcd < r ? xcd * (q + 1) : r * (q + 1) + (xcd - r) * q) + off; }
        const int nig = WGM * nN, gid = wgid / nig, fm = gid * WGM, gsz = (nM - fm) < WGM ? (nM - fm) : WGM;
        u.pm = fm + ((wgid % nig) % gsz); u.pn = (wgid % nig) / gsz; return true;
    }
};

template <class Epi>
__device__ __forceinline__ void gemm_phase(LAS unsigned char* lds, const Gemm g, const StaticOrder& S, const Epi& E) {
    const int tid = threadIdx.x, wid = __builtin_amdgcn_readfirstlane(tid >> 6), lane = tid & 63, wr = wid >> 2, wc = wid & 3, fr = lane & 15, fq = lane >> 4;
    const int K = g.K, nt = K / BK;
    unsigned voffA[2], voffB[2];
#pragma unroll
    for (int i = 0; i < 2; ++i) { int R, C; stage_rc(tid * 16 + i * 8192, R, C); const int Rb = Epi::PERM ? ((R & ~31) + perm32(R & 31)) : R;
        voffA[i] = (unsigned)(R * K + C) * 2u; voffB[i] = (unsigned)(Rb * K + C) * 2u; }
    const size_t kstep = (size_t)(BK * 2);
    const size_t hstep = (size_t)HALF * K * 2;
    const size_t tstep = 2 * hstep;
    const unsigned ldsw = (unsigned)wid * 1024u;
    const int aoff = lds_byte(wr * 64 + fr, fq * 8), boff = lds_byte(wc * 32 + fr, fq * 8);
#define PG8_SA(b, h) (((b) * 2 + (h)) * HTB)
#define PG8_SB(b, h) ((4 + (b) * 2 + (h)) * HTB)
#define PG8_STAGE(bufoff, gbase, voff) do { _Pragma("unroll") for (int _i = 0; _i < 2; ++_i) \
        __builtin_amdgcn_global_load_lds((const unsigned*)((const char*)(gbase) + (voff)[_i]), (LAS unsigned*)(lds + (bufoff) + ldsw + _i * 8192), 16, 0, 0); } while (0)
#define PG8_LDA(dst, b, h) do { _Pragma("unroll") for (int m = 0; m < 4; ++m) _Pragma("unroll") for (int k = 0; k < 2; ++k) dst[m][k] = *(const LAS bf16x8*)(lds + PG8_SA(b, h) + aoff + m * 2048 + k * 1024); } while (0)
#define PG8_LDB(dst, b, h) do { _Pragma("unroll") for (int n = 0; n < 2; ++n) _Pragma("unroll") for (int k = 0; k < 2; ++k) dst[n][k] = *(const LAS bf16x8*)(lds + PG8_SB(b, h) + boff + n * 2048 + k * 1024); } while (0)
#define PG8_MMA(ai, bj, At, Bt) do { __builtin_amdgcn_s_setprio(1); _Pragma("unroll") for (int m = 0; m < 4; ++m) _Pragma("unroll") for (int n = 0; n < 2; ++n) _Pragma("unroll") for (int k = 0; k < 2; ++k) \
        acc[ai][bj][m][n] = __builtin_amdgcn_mfma_f32_16x16x32_bf16(Bt[n][k], At[m][k], acc[ai][bj][m][n], 0, 0, 0); __builtin_amdgcn_s_setprio(0); } while (0)
#define PG8_WAIT_V(n) asm volatile("s_waitcnt vmcnt(" #n ")" ::: "memory")
#define PG8_WAIT_L(n) asm volatile("s_waitcnt lgkmcnt(" #n ")" ::: "memory")
#define PG8_BAR __builtin_amdgcn_s_barrier()
#define PG8_SCHED __builtin_amdgcn_sched_barrier(0)
    Unit cur, nxt; int ui = 0;
    if (!S.next(0, cur)) return;
    f32x4 acc[2][2][4][2];
#pragma unroll
    for (int a = 0; a < 2; ++a)
#pragma unroll
        for (int b = 0; b < 2; ++b)
#pragma unroll
            for (int m = 0; m < 4; ++m)
#pragma unroll
                for (int n = 0; n < 2; ++n) acc[a][b][m][n] = (f32x4){0.f, 0.f, 0.f, 0.f};
    bf16x8 At[4][2], B0[2][2], B1[2][2];
    const char* cA = (const char*)g.A + (size_t)cur.pm * tstep; const char* cB = (const char*)g.Bt + (size_t)cur.pn * tstep;
    PG8_STAGE(PG8_SB(0, 0), cB, voffB); PG8_STAGE(PG8_SA(0, 0), cA, voffA); PG8_STAGE(PG8_SB(0, 1), cB + hstep, voffB); PG8_STAGE(PG8_SA(0, 1), cA + hstep, voffA);
    if (wr == 1) PG8_BAR;
    PG8_WAIT_V(4); PG8_BAR;
    PG8_STAGE(PG8_SB(1, 0), cB + kstep, voffB); PG8_STAGE(PG8_SA(1, 0), cA + kstep, voffA); PG8_STAGE(PG8_SB(1, 1), cB + hstep + kstep, voffB);
    PG8_WAIT_V(6); PG8_BAR;
    for (;;) {
        const bool has_next = S.next(ui + 1, nxt);
        const char* nA = has_next ? (const char*)g.A + (size_t)nxt.pm * tstep : cA; const char* nB = has_next ? (const char*)g.Bt + (size_t)nxt.pn * tstep : cB;
        for (int t = 0; t < nt; t += 2) {
            const bool last = (t == nt - 2);
            const char* a1 = cA + (size_t)(t + 1) * kstep;
            const char* a2 = last ? nA : cA + (size_t)(t + 2) * kstep; const char* b2 = last ? nB : cB + (size_t)(t + 2) * kstep;
            const char* a3 = a2 + kstep; const char* b3 = b2 + kstep;
            PG8_LDB(B0, 0, 0); PG8_SCHED; PG8_LDA(At, 0, 0); PG8_STAGE(PG8_SA(1, 1), a1 + hstep, voffA);
            PG8_WAIT_L(8); PG8_BAR; PG8_WAIT_L(0); PG8_MMA(0, 0, At, B0); PG8_BAR; PG8_SCHED;
            PG8_LDB(B1, 0, 1); PG8_STAGE(PG8_SB(0, 0), b2, voffB);
            PG8_BAR; PG8_WAIT_L(0); PG8_MMA(0, 1, At, B1); PG8_BAR;
            PG8_LDA(At, 0, 1); PG8_STAGE(PG8_SA(0, 0), a2, voffA);
            PG8_BAR; PG8_WAIT_L(0); PG8_MMA(1, 0, At, B0); PG8_BAR; PG8_SCHED;
            PG8_STAGE(PG8_SB(0, 1), b2 + hstep, voffB);
            PG8_WAIT_V(6); PG8_BAR; PG8_MMA(1, 1, At, B1); PG8_BAR;
            PG8_LDB(B0, 1, 0); PG8_SCHED; PG8_LDA(At, 1, 0); PG8_STAGE(PG8_SA(0, 1), a2 + hstep, voffA);
            PG8_WAIT_L(8); PG8_BAR; PG8_WAIT_L(0); PG8_MMA(0, 0, At, B0); PG8_BAR; PG8_SCHED;
            PG8_LDB(B1, 1, 1); PG8_STAGE(PG8_SB(1, 0), b3, voffB);
            PG8_BAR; PG8_WAIT_L(0); PG8_MMA(0, 1, At, B1); PG8_BAR;
            PG8_LDA(At, 1, 1); PG8_STAGE(PG8_SA(1, 0), a3, voffA);
            PG8_BAR; PG8_WAIT_L(0); PG8_MMA(1, 0, At, B0); PG8_BAR; PG8_SCHED;
            PG8_STAGE(PG8_SB(1, 1), b3 + hstep, voffB);
            PG8_WAIT_V(6); PG8_BAR; PG8_MMA(1, 1, At, B1); PG8_BAR;
        }
        E(acc, cur, wr, wc, fr, fq);
        if (!has_next) break;
#pragma unroll
        for (int a = 0; a < 2; ++a)
#pragma unroll
            for (int b = 0; b < 2; ++b)
#pragma unroll
                for (int m = 0; m < 4; ++m)
#pragma unroll
                    for (int n = 0; n < 2; ++n) acc[a][b][m][n] = (f32x4){0.f, 0.f, 0.f, 0.f};
        cur = nxt; cA = nA; cB = nB; ++ui;
    }
    PG8_WAIT_V(0);
    if (wr == 0) PG8_BAR;
    PG8_BAR;
#undef PG8_SA
#undef PG8_SB
#undef PG8_STAGE
#undef PG8_LDA
#undef PG8_LDB
#undef PG8_MMA
#undef PG8_WAIT_V
#undef PG8_WAIT_L
#undef PG8_BAR
#undef PG8_SCHED
}

struct EpiProj {
    static constexpr bool PERM = true;
    bf16_t* O; int ldc;
    __device__ __forceinline__ void operator()(const f32x4 (&acc)[2][2][4][2], const Unit& u, int wr, int wc, int fr, int fq) const {
        const int row0 = u.pm * BM + wr * 64 + fr, col0 = u.pn * BM + wc * 32 + 8 * fq;
#pragma unroll
        for (int ai = 0; ai < 2; ++ai)
#pragma unroll
            for (int m = 0; m < 4; ++m) { bf16_t* rowp = O + (size_t)(row0 + ai * HALF + m * 16) * ldc + col0;
#pragma unroll
                for (int bj = 0; bj < 2; ++bj) { const f32x4 v0 = acc[ai][bj][m][0], v1 = acc[ai][bj][m][1];
                    u32x4 w; w.x = cvt_pk_bf16(v0[0], v0[1]); w.y = cvt_pk_bf16(v0[2], v0[3]); w.z = cvt_pk_bf16(v1[0], v1[1]); w.w = cvt_pk_bf16(v1[2], v1[3]);
                    *(u32x4*)(rowp + bj * HALF) = w; } }
    }
};
struct EpiResid {
    static constexpr bool PERM = false;
    float* out; const float* resP; const float* resS; const float* gate;
    __device__ __forceinline__ void operator()(const f32x4 (&acc)[2][2][4][2], const Unit& u, int wr, int wc, int fr, int fq) const {
        const int col0 = u.pn * BM + wc * 32 + 4 * fq;
#pragma unroll
        for (int ai = 0; ai < 2; ++ai) {
            const int rbase = u.pm * BM + ai * HALF + wr * 64;
            const int s = seq_of_row(rbase);
            f32x4 gv[2][2];
#pragma unroll
            for (int bj = 0; bj < 2; ++bj)
#pragma unroll
                for (int n = 0; n < 2; ++n) gv[bj][n] = *(const f32x4*)(gate + (size_t)s * 12288 + col0 + bj * HALF + n * 16);
#pragma unroll
            for (int m = 0; m < 4; ++m) {
                const int r = rbase + m * 16 + fr;
                const float* rp = (resS == nullptr) ? resP + (size_t)r * DM : (r < 8192 ? resP + (size_t)r * DM : resS + (size_t)(r - 8192) * DM);
                float* op = out + (size_t)r * DM;
#pragma unroll
                for (int bj = 0; bj < 2; ++bj)
#pragma unroll
                    for (int n = 0; n < 2; ++n) { const int c = col0 + bj * HALF + n * 16; const f32x4 rv = *(const f32x4*)(rp + c); *(f32x4*)(op + c) = rv + gv[bj][n] * acc[ai][bj][m][n]; }
            }
        }
    }
};
struct EpiUp {
    static constexpr bool PERM = true;
    bf16_t* act; const float* cw; const float* cb; float* headg; float* headv; float* tailg;
    __device__ __forceinline__ void operator()(const f32x4 (&acc)[2][2][4][2], const Unit& u, int wr, int wc, int fr, int fq) const {
        const int tok0 = u.pm * BM + (wr * 16 + fr) * 8;
        const int sc = tok0 >> 6;
        const bool head = (fr & 7) == 0, tail = (fr & 7) == 7;
#pragma unroll
        for (int n = 0; n < 2; ++n) {
            const int ch0 = u.pn * 128 + wc * 32 + 8 * fq + 4 * n;
            const f32x4 w0 = *(const f32x4*)(cw + ch0), w1 = *(const f32x4*)(cw + DFF + ch0), w2 = *(const f32x4*)(cw + 2 * DFF + ch0), bb = *(const f32x4*)(cb + ch0);
            float o[8][4];
#pragma unroll
            for (int j = 0; j < 4; ++j) {
                float g[8], v[8];
#pragma unroll
                for (int k = 0; k < 8; ++k) { g[k] = acc[k >> 2][0][k & 3][n][j]; v[k] = acc[k >> 2][1][k & 3][n][j]; }
                const float p6 = __shfl_up(g[6], 1, 16), p7 = __shfl_up(g[7], 1, 16);
                o[0][j] = siluf(w0[j] * p6 + w1[j] * p7 + w2[j] * g[0] + bb[j]) * v[0];
                o[1][j] = siluf(w0[j] * p7 + w1[j] * g[0] + w2[j] * g[1] + bb[j]) * v[1];
#pragma unroll
                for (int k = 2; k < 8; ++k) o[k][j] = siluf(w0[j] * g[k - 2] + w1[j] * g[k - 1] + w2[j] * g[k] + bb[j]) * v[k];
            }
#pragma unroll
            for (int k = 0; k < 8; ++k) {
                if (k < 2 && head) continue;
                u32x2 w; w.x = cvt_pk_bf16(o[k][0], o[k][1]); w.y = cvt_pk_bf16(o[k][2], o[k][3]);
                *(u32x2*)(act + (size_t)(tok0 + k) * DFF + ch0) = w;
            }
            if (head) {
#pragma unroll
                for (int k = 0; k < 2; ++k) {
                    *(f32x4*)(headg + ((size_t)sc * 2 + k) * DFF + ch0) = (f32x4){acc[0][0][k][n][0], acc[0][0][k][n][1], acc[0][0][k][n][2], acc[0][0][k][n][3]};
                    *(f32x4*)(headv + ((size_t)sc * 2 + k) * DFF + ch0) = (f32x4){acc[0][1][k][n][0], acc[0][1][k][n][1], acc[0][1][k][n][2], acc[0][1][k][n][3]};
                }
            }
            if (tail) {
#pragma unroll
                for (int k = 0; k < 2; ++k)
                    *(f32x4*)(tailg + ((size_t)sc * 2 + k) * DFF + ch0) = (f32x4){acc[1][0][2 + k][n][0], acc[1][0][2 + k][n][1], acc[1][0][2 + k][n][2], acc[1][0][2 + k][n][3]};
            }
        }
    }
};
}

__device__ __forceinline__ float softplusf(float x) { return x > 20.f ? x : log1pf(__expf(x)); }

__device__ __forceinline__ void gdn_prep(CPARAMS p, unsigned char* lds, int sc, int hd) {
    const int tid = threadIdx.x, w = tid >> 6, lane = tid & 63, fr = lane & 15, fq = lane >> 4;
    float* qf = (float*)lds; float* kf = qf + 64 * 129; float* vf = kf + 64 * 129;
    bf16_t* qn = (bf16_t*)(lds + 99072); bf16_t* kn = qn + 64 * 136;
    float* sm = (float*)(lds + 133888); float* beta = sm; float* Gc = sm + 64; float* rq = sm + 128; float* rk = sm + 192; float* gt = sm + 256; float* eg = sm + 320;
    float* Am = qf;
    bf16_t* Abf = (bf16_t*)(lds + 16384);
    bf16_t* WT = (bf16_t*)(lds + 99072);
    const bf16_t* proj = (const bf16_t*)(p.ws + WS_PROJ);
    const float* psm = (const float*)(p.ws + WS_PSMALL);
    const int row0 = sc * 64;
    const bool sample = sc >= 128, first = sample || ((sc & 31) == 0), lastc = sample || ((sc & 31) == 31);
    const int s = sample ? 4 + (sc - 128) : (sc >> 5);
    unsigned char* ops = p.ws + WS_OPS + (size_t)(sc * 12 + 4 + hd) * OPS_UNIT;
    bf16_t* o_wvT = (bf16_t*)ops; bf16_t* o_wk = (bf16_t*)(ops + 16384); bf16_t* o_attn = (bf16_t*)(ops + 32768); bf16_t* o_qg = (bf16_t*)(ops + 40960); bf16_t* o_kgT = (bf16_t*)(ops + 57344);
    float* outc = p.out + (s < 4 ? OUT_P_CONV + (size_t)s * 9216 : OUT_S_CONV + (size_t)(s - 4) * 9216);
    {
        const int d = tid & 127, tg = tid >> 7, t0 = tg * 16;
#pragma unroll
        for (int mat = 0; mat < 3; ++mat) {
            const int pc = PC_GDN_Q + mat * 1024 + hd * 128 + d, cc = mat * 1024 + hd * 128 + d;
            const float w0 = p.gdn_conv_w[cc], w1 = p.gdn_conv_w[3072 + cc], w2 = p.gdn_conv_w[2 * 3072 + cc], w3 = p.gdn_conv_w[3 * 3072 + cc];
            float h[3];
#pragma unroll
            for (int j = 1; j <= 3; ++j) {
                const int tt = t0 - j; float val;
                if (tt >= 0 || !first) val = bf2f(proj[(size_t)(row0 + tt) * NPROJ + pc]);
                else if (sample) val = p.state_gdn_conv[(size_t)(s - 4) * 9216 + (3 + tt) * 3072 + cc];
                else val = 0.f;
                h[j - 1] = val;
            }
            float xm1 = h[0], xm2 = h[1], xm3 = h[2];
            float* dst = mat == 0 ? qf : (mat == 1 ? kf : vf);
            const bf16_t* pr = proj + (size_t)(row0 + t0) * NPROJ + pc;
            bf16_t xr[16];
#pragma unroll
            for (int i = 0; i < 16; ++i) { asm volatile("" : "+v"(pr)); xr[i] = *pr; pr += NPROJ; }
#pragma unroll
            for (int i = 0; i < 16; ++i) {
                const float x0 = bf2f(xr[i]);
                const float y = w0 * xm3 + w1 * xm2 + w2 * xm1 + w3 * x0;
                dst[(t0 + i) * 129 + d] = siluf(y);
                if (lastc && (t0 + i) >= 61) outc[(t0 + i - 61) * 3072 + cc] = x0;
                xm3 = xm2; xm2 = xm1; xm1 = x0;
            }
        }
    }
    __syncthreads();
    {
        const int t = tid >> 3, part = tid & 7; float sq = 0.f, sk = 0.f;
#pragma unroll
        for (int j = 0; j < 16; ++j) { const float a = qf[t * 129 + part * 16 + j], b = kf[t * 129 + part * 16 + j]; sq += a * a; sk += b * b; }
        sq += __shfl_xor(sq, 1); sq += __shfl_xor(sq, 2); sq += __shfl_xor(sq, 4);
        sk += __shfl_xor(sk, 1); sk += __shfl_xor(sk, 2); sk += __shfl_xor(sk, 4);
        if (part == 0) { rq[t] = rsqrtf(sq + EPSF) * 0.08838834764831845f; rk[t] = rsqrtf(sk + EPSF); }
        if (tid < 64) {
            const float* ps = psm + (size_t)(row0 + tid) * 32;
            beta[tid] = 1.f / (1.f + __expf(-ps[16 + hd]));
            gt[tid] = -__expf(p.gdn_a_log[hd]) * softplusf(ps[24 + hd] + p.gdn_dt_bias[hd]);
        }
    }
    __syncthreads();
    if (tid == 0) { float c = 0.f; for (int t = 0; t < 64; ++t) { c += gt[t]; Gc[t] = c; } }
    __syncthreads();
    if (tid < 64) eg[tid] = __expf(Gc[tid]);
    for (int idx = tid; idx < 64 * 128; idx += 512) {
        const int t = idx >> 7, d = idx & 127;
        const float q = qf[t * 129 + d] * rq[t], k = kf[t * 129 + d] * rk[t];
        qn[t * 136 + d] = f2bf(q); kn[t * 136 + d] = f2bf(k); kf[t * 129 + d] = k;
    }
    __syncthreads();
    for (int b = w; b < 32; b += 8) {
        const int which = b >> 4, blk = b & 15, mi = blk >> 2, nj = blk & 3;
        const int i = 16 * mi + fr, j0 = 16 * nj + 4 * fq;
        if (nj > mi) { if (which) *(u32x2*)(o_attn + i * 64 + j0) = (u32x2){0u, 0u}; continue; }
        f32x4 D = {0.f, 0.f, 0.f, 0.f};
        const bf16_t* Z = which ? qn : kn;
#pragma unroll
        for (int ks = 0; ks < 4; ++ks) D = mfma16(ldfrag(kn, 16 * nj + fr, 136, ks * 32 + fq * 8), ldfrag(Z, 16 * mi + fr, 136, ks * 32 + fq * 8), D);
        float r[4];
#pragma unroll
        for (int e = 0; e < 4; ++e) {
            const int j = j0 + e; const float dec = __expf(Gc[i] - Gc[j]);
            if (which) r[e] = (j <= i) ? D[e] * dec : 0.f; else r[e] = (j < i) ? D[e] * dec * beta[i] : 0.f;
        }
        if (which) { u32x2 pk; pk.x = cvt_pk_bf16(r[0], r[1]); pk.y = cvt_pk_bf16(r[2], r[3]); *(u32x2*)(o_attn + i * 64 + j0) = pk; }
        else { *(f32x4*)(Am + i * 64 + j0) = (f32x4){r[0], r[1], r[2], r[3]}; u32x2 pk; pk.x = cvt_pk_bf16(r[0], r[1]); pk.y = cvt_pk_bf16(r[2], r[3]); *(u32x2*)(Abf + i * 72 + j0) = pk; }
    }
    {
        const float Gl = Gc[63];
        for (int idx = tid; idx < 1024; idx += 512) {
            const int t = idx >> 4, d8 = (idx & 15) * 8; const float eg = __expf(Gc[t]);
            float v[8];
#pragma unroll
            for (int j = 0; j < 8; ++j) v[j] = bf2f(qn[t * 136 + d8 + j]) * eg;
            u32x4 pk; pk.x = cvt_pk_bf16(v[0], v[1]); pk.y = cvt_pk_bf16(v[2], v[3]); pk.z = cvt_pk_bf16(v[4], v[5]); pk.w = cvt_pk_bf16(v[6], v[7]);
            *(u32x4*)(o_qg + t * 128 + d8) = pk;
        }
        for (int idx = tid; idx < 1024; idx += 512) {
            const int d = idx >> 3, t8 = (idx & 7) * 8;
            float v[8];
#pragma unroll
            for (int j = 0; j < 8; ++j) v[j] = bf2f(kn[(t8 + j) * 136 + d]) * __expf(Gl - Gc[t8 + j]);
            u32x4 pk; pk.x = cvt_pk_bf16(v[0], v[1]); pk.y = cvt_pk_bf16(v[2], v[3]); pk.z = cvt_pk_bf16(v[4], v[5]); pk.w = cvt_pk_bf16(v[6], v[7]);
            *(u32x4*)(o_kgT + d * 64 + t8) = pk;
        }
        if (tid == 0) ((float*)(p.ws + WS_GLAST))[(size_t)(sc * 12 + 4 + hd) * 128] = __expf(Gl);
    }
    __syncthreads();
    {
        u32x4 z = {0u, 0u, 0u, 0u};
        u32x4* zp = (u32x4*)(WT + (32 * w) * 64 + lane * 32);
        zp[0] = z; zp[1] = z; zp[2] = z; zp[3] = z;
        asm volatile("s_waitcnt lgkmcnt(0)" ::: "memory");
#pragma unroll 1
        for (int b = 0; b < 4; ++b) {
#pragma unroll 1
            for (int cbi = 0; cbi < 2; ++cbi) {
                const int cb = 2 * w + cbi, c = 16 * cb + fr;
                float m4[4];
#pragma unroll
                for (int e = 0; e < 4; ++e) {
                    const int i = 16 * b + 4 * fq + e;
                    m4[e] = (w < 4) ? vf[i * 129 + c] * beta[i] : kf[i * 129 + (c - 128)] * beta[i] * eg[i];
                }
                if (b > 0) {
                    f32x4 D = {0.f, 0.f, 0.f, 0.f};
#pragma unroll
                    for (int ks = 0; ks < 2; ++ks) if (ks == 0 || b == 3) D = mfma16(ldfrag(Abf, 16 * b + fr, 72, ks * 32 + fq * 8), ldfrag(WT, 16 * cb + fr, 64, ks * 32 + fq * 8), D);
#pragma unroll
                    for (int e = 0; e < 4; ++e) m4[e] -= D[e];
                }
                float m[16];
#pragma unroll
                for (int q = 0; q < 4; ++q)
#pragma unroll
                    for (int e = 0; e < 4; ++e) m[4 * q + e] = __shfl(m4[e], fr + 16 * q, 64);
#pragma unroll
                for (int i = 1; i < 16; ++i) {
                    const float* arow = Am + (16 * b + i) * 64 + 16 * b;
                    float r0 = m[i];
                    asm volatile("" : "+v"(r0) :: "memory");
#pragma unroll
                    for (int j = 0; j < i; ++j) r0 -= arow[j] * m[j];
                    m[i] = r0;
                }
                if (fq == 0) {
                    u32x4 p0, p1;
                    p0.x = cvt_pk_bf16(m[0], m[1]); p0.y = cvt_pk_bf16(m[2], m[3]); p0.z = cvt_pk_bf16(m[4], m[5]); p0.w = cvt_pk_bf16(m[6], m[7]);
                    p1.x = cvt_pk_bf16(m[8], m[9]); p1.y = cvt_pk_bf16(m[10], m[11]); p1.z = cvt_pk_bf16(m[12], m[13]); p1.w = cvt_pk_bf16(m[14], m[15]);
                    *(u32x4*)(WT + c * 64 + 16 * b) = p0; *(u32x4*)(WT + c * 64 + 16 * b + 8) = p1;
                }
            }
            asm volatile("s_waitcnt lgkmcnt(0)" ::: "memory");
        }
    }
    __syncthreads();
    for (int idx = tid; idx < 1024; idx += 512) *(u32x4*)(o_wvT + idx * 8) = *(const u32x4*)(WT + idx * 8);
    for (int idx = tid; idx < 1024; idx += 512) {
        const int t = idx >> 4, d8 = (idx & 15) * 8; unsigned short v[8];
#pragma unroll
        for (int j = 0; j < 8; ++j) v[j] = WT[(128 + d8 + j) * 64 + t];
        u32x4 pk; pk.x = v[0] | ((unsigned)v[1] << 16); pk.y = v[2] | ((unsigned)v[3] << 16); pk.z = v[4] | ((unsigned)v[5] << 16); pk.w = v[6] | ((unsigned)v[7] << 16);
        *(u32x4*)(o_wk + t * 128 + d8) = pk;
    }
    __syncthreads();
}

__device__ __forceinline__ void gla_prep(CPARAMS p, unsigned char* lds, int sc, int h) {
    const int tid = threadIdx.x, w = tid >> 6, lane = tid & 63, fr = lane & 15, fq = lane >> 4;
    bf16_t* kraw = (bf16_t*)lds; bf16_t* qraw = (bf16_t*)(lds + 17408); float* Gm = (float*)(lds + 34816);
    bf16_t* qgl = (bf16_t*)(lds + 67840); bf16_t* kdl = (bf16_t*)(lds + 85248); float* alr = (float*)(lds + 102656); float* gsum = (float*)(lds + 106752);
    bf16_t* vl = (bf16_t*)(lds + 108800);
    const bf16_t* proj = (const bf16_t*)(p.ws + WS_PROJ);
    const float* psm = (const float*)(p.ws + WS_PSMALL);
    const int row0 = sc * 64;
    unsigned char* ops = p.ws + WS_OPS + (size_t)(sc * 12 + h) * OPS_UNIT;
    bf16_t* o_vT = (bf16_t*)ops; bf16_t* o_attn = (bf16_t*)(ops + 32768); bf16_t* o_qg = (bf16_t*)(ops + 40960); bf16_t* o_kgT = (bf16_t*)(ops + 57344);
#pragma unroll
    for (int i = 0; i < 2; ++i) { const int idx = tid + 512 * i, t = idx >> 4, seg = idx & 15;
        *(u32x4*)(qraw + t * 136 + seg * 8) = *(const u32x4*)(proj + (size_t)(row0 + t) * NPROJ + PC_GLA_Q + h * 128 + seg * 8);
        *(u32x4*)(kraw + t * 136 + seg * 8) = *(const u32x4*)(proj + (size_t)(row0 + t) * NPROJ + PC_GLA_K + h * 128 + seg * 8); }
#pragma unroll
    for (int i = 0; i < 4; ++i) { const int idx = tid + 512 * i, t = idx >> 5, seg = idx & 31;
        *(u32x4*)(vl + t * 264 + seg * 8) = *(const u32x4*)(proj + (size_t)(row0 + t) * NPROJ + PC_GLA_V + h * 256 + seg * 8); }
    if (tid < 256) { const int t = tid >> 2, q4 = (tid & 3) * 4; *(float4*)(alr + t * 16 + q4) = *(const float4*)(psm + (size_t)(row0 + t) * 32 + q4); }
    __syncthreads();
    const int d = tid & 127, tg = tid >> 7;
    {
        float wg[16];
#pragma unroll
        for (int r = 0; r < 16; ++r) wg[r] = p.gla_wg[r * 512 + h * 128 + d];
        const float bg = p.gla_bg[h * 128 + d];
        float run = 0.f;
#pragma unroll
        for (int i = 0; i < 16; ++i) {
            const int t = tg * 16 + i; float z = bg;
#pragma unroll
            for (int r = 0; r < 16; ++r) z += alr[t * 16 + r] * wg[r];
            const float la = (fminf(z, 0.f) - log1pf(__expf(-fabsf(z)))) * (1.f / 16.f);
            run += la; Gm[t * 129 + d] = run;
        }
        gsum[tg * 128 + d] = run;
    }
    __syncthreads();
    {
        float off = 0.f, Gl = 0.f;
#pragma unroll
        for (int g = 0; g < 4; ++g) { const float v = gsum[g * 128 + d]; if (g < tg) off += v; Gl += v; }
#pragma unroll
        for (int i = 0; i < 16; ++i) {
            const int t = tg * 16 + i; const float G = Gm[t * 129 + d] + off;
            const float q = bf2f(qraw[t * 136 + d]) * 0.08838834764831845f, k = bf2f(kraw[t * 136 + d]);
            qgl[t * 136 + d] = f2bf(q * __expf(G)); kdl[t * 136 + d] = f2bf(k * __expf(-G)); kraw[t * 136 + d] = f2bf(k * __expf(Gl - G));
        }
        if (tg == 0) ((float*)(p.ws + WS_GLAST))[(size_t)(sc * 12 + h) * 128 + d] = __expf(Gl);
    }
    __syncthreads();
#if !defined(GLA_DBG) || GLA_DBG >= 2
#endif
{
    for (int idx = tid; idx < 1024; idx += 512) { const int t = idx >> 4, seg = idx & 15; *(u32x4*)(o_qg + t * 128 + seg * 8) = *(const u32x4*)(qgl + t * 136 + seg * 8); }
#if !defined(GLA_DBG) || GLA_DBG >= 3
    for (int idx = tid; idx < 1024; idx += 512) {
        const int dd = idx >> 3, t8 = (idx & 7) * 8; unsigned short v[8];
#pragma unroll
        for (int j = 0; j < 8; ++j) v[j] = kraw[(t8 + j) * 136 + dd];
        u32x4 pk; pk.x = v[0] | ((unsigned)v[1] << 16); pk.y = v[2] | ((unsigned)v[3] << 16); pk.z = v[4] | ((unsigned)v[5] << 16); pk.w = v[6] | ((unsigned)v[7] << 16);
        *(u32x4*)(o_kgT + dd * 64 + t8) = pk;
    }
    for (int idx = tid; idx < 2048; idx += 512) {
        const int dv = idx >> 3, t8 = (idx & 7) * 8; unsigned short v[8];
#pragma unroll
        for (int j = 0; j < 8; ++j) v[j] = vl[(t8 + j) * 264 + dv];
        u32x4 pk; pk.x = v[0] | ((unsigned)v[1] << 16); pk.y = v[2] | ((unsigned)v[3] << 16); pk.z = v[4] | ((unsigned)v[5] << 16); pk.w = v[6] | ((unsigned)v[7] << 16);
        *(u32x4*)(o_vT + dv * 64 + t8) = pk;
    }
    for (int b = w; b < 16; b += 8) {
        const int mi = b >> 2, nj = b & 3; const int i = 16 * mi + fr, j0 = 16 * nj + 4 * fq;
        if (nj > mi) { *(u32x2*)(o_attn + i * 64 + j0) = (u32x2){0u, 0u}; continue; }
        f32x4 D = {0.f, 0.f, 0.f, 0.f};
#pragma unroll
        for (int ks = 0; ks < 4; ++ks) D = mfma16(ldfrag(kdl, 16 * nj + fr, 136, ks * 32 + fq * 8), ldfrag(qgl, 16 * mi + fr, 136, ks * 32 + fq * 8), D);
        float r[4];
#pragma unroll
        for (int e = 0; e < 4; ++e) r[e] = (j0 + e <= i) ? D[e] : 0.f;
        u32x2 pk; pk.x = cvt_pk_bf16(r[0], r[1]); pk.y = cvt_pk_bf16(r[2], r[3]); *(u32x2*)(o_attn + i * 64 + j0) = pk;
    }
#endif
}
    __syncthreads();
}

__device__ __forceinline__ void phase_chunk_prep(CPARAMS p, unsigned char* lds) {
#ifndef NO_GDN_PREP
    for (int u = blockIdx.x; u < NCHUNK * 8; u += gridDim.x) gdn_prep(p, lds, u >> 3, u & 7);
#endif
    asm volatile("" ::: "memory");
#ifndef NO_GLA_PREP
    for (int u = (blockIdx.x + 128) % gridDim.x; u < NCHUNK * 4; u += gridDim.x) gla_prep(p, lds, u >> 2, u & 3);
#endif
}

__device__ __forceinline__ void gdn_chain(CPARAMS p, unsigned char* lds, int s, int hd) {
    const int tid = threadIdx.x, w = tid >> 6, lane = tid & 63, fr = lane & 15, fq = lane >> 4;
    bf16_t* Wk = (bf16_t*)lds; bf16_t* qg = (bf16_t*)(lds + 17408); bf16_t* attn = (bf16_t*)(lds + 34816); bf16_t* kgT = (bf16_t*)(lds + 44032);
    bf16_t* WvT = (bf16_t*)(lds + 62464); bf16_t* ST = (bf16_t*)(lds + 80896); bf16_t* uT = (bf16_t*)(lds + 115712); float* red = (float*)(lds + 134144);
    const int nch = s < 4 ? 32 : 1, sc0 = s < 4 ? s * 32 : 128 + (s - 4);
    const bf16_t* proj = (const bf16_t*)(p.ws + WS_PROJ);
    bf16_t* mixo = (bf16_t*)(p.ws + WS_MIXO);
    const float* glast = (const float*)(p.ws + WS_GLAST);
    const int dvr = 16 * w + fr;
    f32x4 sacc[8];
#pragma unroll
    for (int nb = 0; nb < 8; ++nb) {
        if (s >= 4) {
            const float* st = p.state_gdn + (size_t)((s - 4) * 8 + hd) * 16384 + (size_t)(16 * nb + 4 * fq) * 128 + dvr;
            asm volatile("" : "+v"(st));
#pragma unroll
            for (int e = 0; e < 4; ++e) sacc[nb][e] = st[e * 128];
        } else sacc[nb] = (f32x4){0.f, 0.f, 0.f, 0.f};
        u32x2 pk; pk.x = cvt_pk_bf16(sacc[nb][0], sacc[nb][1]); pk.y = cvt_pk_bf16(sacc[nb][2], sacc[nb][3]);
        *(u32x2*)(ST + dvr * 136 + 16 * nb + 4 * fq) = pk;
    }
    u32x4 pf[9];
    {
        const u32x4* src = (const u32x4*)(p.ws + WS_OPS + (size_t)(sc0 * 12 + 4 + hd) * OPS_UNIT);
#pragma unroll
        for (int i = 0; i < 9; ++i) pf[i] = src[tid + 512 * i];
    }
    for (int c = 0; c < nch; ++c) {
        const int sc = sc0 + c; int row0 = sc * 64; asm volatile("" : "+v"(row0));
#pragma unroll
        for (int i = 0; i < 9; ++i) {
            const int q = tid + 512 * i;
            bf16_t* dst;
            if (i < 2) dst = WvT + (q >> 3) * 72 + (q & 7) * 8;
            else if (i < 4) { const int q2 = q - 1024; dst = Wk + (q2 >> 4) * 136 + (q2 & 15) * 8; }
            else if (i < 5) { const int q2 = q - 2048; dst = attn + (q2 >> 3) * 72 + (q2 & 7) * 8; }
            else if (i < 7) { const int q2 = q - 2560; dst = qg + (q2 >> 4) * 136 + (q2 & 15) * 8; }
            else { const int q2 = q - 3584; dst = kgT + (q2 >> 3) * 72 + (q2 & 7) * 8; }
            *(u32x4*)dst = pf[i];
        }
        const float decay = glast[(size_t)(sc * 12 + 4 + hd) * 128];
        __syncthreads();
        u32x2 gtv[4];
#pragma unroll
        for (int tb = 0; tb < 4; ++tb) gtv[tb] = *(const u32x2*)(proj + (size_t)(row0 + 16 * tb + fr) * NPROJ + PC_GDN_G + hd * 128 + 16 * w + 4 * fq);
        if (c + 1 < nch) {
            const u32x4* src = (const u32x4*)(p.ws + WS_OPS + (size_t)((sc + 1) * 12 + 4 + hd) * OPS_UNIT);
#pragma unroll
            for (int i = 0; i < 9; ++i) pf[i] = src[tid + 512 * i];
        }
        bf16x8 stf[4];
#pragma unroll
        for (int ks = 0; ks < 4; ++ks) stf[ks] = ldfrag(ST, dvr, 136, ks * 32 + fq * 8);
#pragma unroll
        for (int tb = 0; tb < 4; ++tb) {
            f32x4 D = {0.f, 0.f, 0.f, 0.f};
#pragma unroll
            for (int ks = 0; ks < 4; ++ks) D = mfma16(ldfrag(Wk, 16 * tb + fr, 136, ks * 32 + fq * 8), stf[ks], D);
            const u32x2 wv = *(const u32x2*)(WvT + dvr * 72 + 16 * tb + 4 * fq);
            u32x2 pk; pk.x = cvt_pk_bf16(bflo(wv.x) - D[0], bfhi(wv.x) - D[1]); pk.y = cvt_pk_bf16(bflo(wv.y) - D[2], bfhi(wv.y) - D[3]);
            *(u32x2*)(uT + dvr * 72 + 16 * tb + 4 * fq) = pk;
        }
        asm volatile("s_waitcnt lgkmcnt(0)" ::: "memory");
        bf16x8 utf[2];
#pragma unroll
        for (int ks = 0; ks < 2; ++ks) utf[ks] = ldfrag(uT, dvr, 72, ks * 32 + fq * 8);
        f32x4 o[4];
#pragma unroll
        for (int tb = 0; tb < 4; ++tb) {
            f32x4 D = {0.f, 0.f, 0.f, 0.f};
#pragma unroll
            for (int ks = 0; ks < 4; ++ks) D = mfma16(stf[ks], ldfrag(qg, 16 * tb + fr, 136, ks * 32 + fq * 8), D);
#pragma unroll
            for (int ks = 0; ks < 2; ++ks) D = mfma16(utf[ks], ldfrag(attn, 16 * tb + fr, 72, ks * 32 + fq * 8), D);
            o[tb] = D;
            float ss = D[0] * D[0] + D[1] * D[1] + D[2] * D[2] + D[3] * D[3];
            ss += __shfl_xor(ss, 16); ss += __shfl_xor(ss, 32);
            if (fq == 0) red[w * 64 + 16 * tb + fr] = ss;
        }
#pragma unroll
        for (int nb = 0; nb < 8; ++nb) {
            f32x4 a = sacc[nb] * decay;
#pragma unroll
            for (int ks = 0; ks < 2; ++ks) a = mfma16(ldfrag(kgT, 16 * nb + fr, 72, ks * 32 + fq * 8), utf[ks], a);
            sacc[nb] = a;
            u32x2 pk; pk.x = cvt_pk_bf16(a[0], a[1]); pk.y = cvt_pk_bf16(a[2], a[3]);
            *(u32x2*)(ST + dvr * 136 + 16 * nb + 4 * fq) = pk;
        }
        __syncthreads();
        {
            const int dv0 = 16 * w + 4 * fq;
            const f32x4 nrm = *(const f32x4*)(p.gdn_norm + dv0);
#pragma unroll
            for (int tb = 0; tb < 4; ++tb) {
                const int t = 16 * tb + fr; float tot = 0.f;
#pragma unroll
                for (int i = 0; i < 8; ++i) tot += red[i * 64 + t];
                const float rstd = rsqrtf(tot * (1.f / 128.f) + EPSF);
                const size_t row = (size_t)(row0 + t);
                const u32x2 gt = gtv[tb];
                const float g0 = siluf(bflo(gt.x)), g1 = siluf(bfhi(gt.x)), g2 = siluf(bflo(gt.y)), g3 = siluf(bfhi(gt.y));
                u32x2 pk; pk.x = cvt_pk_bf16(o[tb][0] * rstd * nrm[0] * g0, o[tb][1] * rstd * nrm[1] * g1); pk.y = cvt_pk_bf16(o[tb][2] * rstd * nrm[2] * g2, o[tb][3] * rstd * nrm[3] * g3);
                *(u32x2*)(mixo + row * DM + 1024 + hd * 128 + dv0) = pk;
            }
        }
        __syncthreads();
    }
    float* so = p.out + (s < 4 ? OUT_P_GDN + (size_t)(s * 8 + hd) * 16384 : OUT_S_GDN + (size_t)((s - 4) * 8 + hd) * 16384);
#pragma unroll
    for (int nb = 0; nb < 8; ++nb)
        { float* q = so + (size_t)(16 * nb + 4 * fq) * 128 + dvr; asm volatile("" : "+v"(q));
#pragma unroll
          for (int e = 0; e < 4; ++e) q[e * 128] = sacc[nb][e]; }
}

__device__ __forceinline__ void gla_chain(CPARAMS p, unsigned char* lds, int s, int h) {
    const int tid = threadIdx.x, w = tid >> 6, lane = tid & 63, fr = lane & 15, fq = lane >> 4;
    bf16_t* qg = (bf16_t*)lds; bf16_t* attn = (bf16_t*)(lds + 17408); bf16_t* kgT = (bf16_t*)(lds + 26624); bf16_t* vT = (bf16_t*)(lds + 45056);
    bf16_t* ST = (bf16_t*)(lds + 81920); float* red = (float*)(lds + 151552); float* gl = (float*)(lds + 153600);
    const int nch = s < 4 ? 32 : 1, sc0 = s < 4 ? s * 32 : 128 + (s - 4);
    const bf16_t* proj = (const bf16_t*)(p.ws + WS_PROJ);
    bf16_t* mixo = (bf16_t*)(p.ws + WS_MIXO);
    const float* glast = (const float*)(p.ws + WS_GLAST);
    f32x4 sacc[2][8];
#pragma unroll
    for (int db = 0; db < 2; ++db) {
        const int dvr = 32 * w + 16 * db + fr;
#pragma unroll
        for (int nb = 0; nb < 8; ++nb) {
            if (s >= 4) {
                const float* st = p.state_gla + (size_t)((s - 4) * 4 + h) * 32768 + (size_t)(16 * nb + 4 * fq) * 256 + dvr;
                asm volatile("" : "+v"(st));
#pragma unroll
                for (int e = 0; e < 4; ++e) sacc[db][nb][e] = st[e * 256];
            } else sacc[db][nb] = (f32x4){0.f, 0.f, 0.f, 0.f};
            u32x2 pk; pk.x = cvt_pk_bf16(sacc[db][nb][0], sacc[db][nb][1]); pk.y = cvt_pk_bf16(sacc[db][nb][2], sacc[db][nb][3]);
            *(u32x2*)(ST + dvr * 136 + 16 * nb + 4 * fq) = pk;
        }
    }
    u32x4 pf[9]; float glp = 0.f;
    {
        const u32x4* src = (const u32x4*)(p.ws + WS_OPS + (size_t)(sc0 * 12 + h) * OPS_UNIT);
#pragma unroll
        for (int i = 0; i < 9; ++i) pf[i] = src[tid + 512 * i];
        if (tid < 128) glp = glast[(size_t)(sc0 * 12 + h) * 128 + tid];
    }
    for (int c = 0; c < nch; ++c) {
        const int sc = sc0 + c; int row0 = sc * 64; asm volatile("" : "+v"(row0));
#pragma unroll
        for (int i = 0; i < 9; ++i) {
            const int q = tid + 512 * i;
            bf16_t* dst;
            if (i < 4) dst = vT + (q >> 3) * 72 + (q & 7) * 8;
            else if (i < 5) { const int q2 = q - 2048; dst = attn + (q2 >> 3) * 72 + (q2 & 7) * 8; }
            else if (i < 7) { const int q2 = q - 2560; dst = qg + (q2 >> 4) * 136 + (q2 & 15) * 8; }
            else { const int q2 = q - 3584; dst = kgT + (q2 >> 3) * 72 + (q2 & 7) * 8; }
            *(u32x4*)dst = pf[i];
        }
        if (tid < 128) gl[tid] = glp;
        __syncthreads();
        f32x4 o[2][4];
        float ssum[4] = {0.f, 0.f, 0.f, 0.f};
        bf16x8 vtf[2][2];
#pragma unroll
        for (int db = 0; db < 2; ++db) {
            asm volatile("" ::: "memory");
            const int dvr = 32 * w + 16 * db + fr;
            bf16x8 stf[4];
#pragma unroll
            for (int ks = 0; ks < 4; ++ks) stf[ks] = ldfrag(ST, dvr, 136, ks * 32 + fq * 8);
#pragma unroll
            for (int ks = 0; ks < 2; ++ks) vtf[db][ks] = ldfrag(vT, dvr, 72, ks * 32 + fq * 8);
#pragma unroll
            for (int tb = 0; tb < 4; ++tb) {
                f32x4 D = {0.f, 0.f, 0.f, 0.f};
#pragma unroll
                for (int ks = 0; ks < 4; ++ks) D = mfma16(stf[ks], ldfrag(qg, 16 * tb + fr, 136, ks * 32 + fq * 8), D);
#pragma unroll
                for (int ks = 0; ks < 2; ++ks) D = mfma16(vtf[db][ks], ldfrag(attn, 16 * tb + fr, 72, ks * 32 + fq * 8), D);
                o[db][tb] = D;
                ssum[tb] += D[0] * D[0] + D[1] * D[1] + D[2] * D[2] + D[3] * D[3];
            }
        }
#pragma unroll
        for (int tb = 0; tb < 4; ++tb) { float ss = ssum[tb]; ss += __shfl_xor(ss, 16); ss += __shfl_xor(ss, 32); if (fq == 0) red[w * 64 + 16 * tb + fr] = ss; }
        asm volatile("" ::: "memory");
        if (c + 1 < nch) {
            const u32x4* src = (const u32x4*)(p.ws + WS_OPS + (size_t)((sc + 1) * 12 + h) * OPS_UNIT);
#pragma unroll
            for (int i = 0; i < 9; ++i) pf[i] = src[tid + 512 * i];
            if (tid < 128) glp = glast[(size_t)((sc + 1) * 12 + h) * 128 + tid];
        }
#pragma unroll
        for (int nb = 0; nb < 8; ++nb) {
            const f32x4 dec = *(const f32x4*)(gl + 16 * nb + 4 * fq);
            bf16x8 kf0 = ldfrag(kgT, 16 * nb + fr, 72, fq * 8), kf1 = ldfrag(kgT, 16 * nb + fr, 72, 32 + fq * 8);
#pragma unroll
            for (int db = 0; db < 2; ++db) {
                const int dvr = 32 * w + 16 * db + fr;
                f32x4 a = sacc[db][nb] * dec;
                a = mfma16(kf0, vtf[db][0], a); a = mfma16(kf1, vtf[db][1], a);
                sacc[db][nb] = a;
                u32x2 pk; pk.x = cvt_pk_bf16(a[0], a[1]); pk.y = cvt_pk_bf16(a[2], a[3]);
                *(u32x2*)(ST + dvr * 136 + 16 * nb + 4 * fq) = pk;
            }
        }
        __syncthreads();
#pragma unroll
        for (int tb = 0; tb < 4; ++tb) {
            const int t = 16 * tb + fr; float tot = 0.f;
#pragma unroll
            for (int i = 0; i < 8; ++i) tot += red[i * 64 + t];
            const float rstd = rsqrtf(tot * (1.f / 256.f) + EPSF);
            const size_t row = (size_t)(row0 + t);
#pragma unroll
            for (int db = 0; db < 2; ++db) {
                const int dv0 = 32 * w + 16 * db + 4 * fq;
                const f32x4 nrm = *(const f32x4*)(p.gla_norm + dv0);
                const u32x2 gt = *(const u32x2*)(proj + row * NPROJ + PC_GLA_R + h * 256 + dv0);
                const float g0 = siluf(bflo(gt.x)), g1 = siluf(bfhi(gt.x)), g2 = siluf(bflo(gt.y)), g3 = siluf(bfhi(gt.y));
                const f32x4 ov = o[db][tb];
                u32x2 pk; pk.x = cvt_pk_bf16(ov[0] * rstd * nrm[0] * g0, ov[1] * rstd * nrm[1] * g1); pk.y = cvt_pk_bf16(ov[2] * rstd * nrm[2] * g2, ov[3] * rstd * nrm[3] * g3);
                *(u32x2*)(mixo + row * DM + h * 256 + dv0) = pk;
            }
        }
        __syncthreads();
    }
    float* so = p.out + (s < 4 ? OUT_P_GLA + (size_t)(s * 4 + h) * 32768 : OUT_S_GLA + (size_t)((s - 4) * 4 + h) * 32768);
#pragma unroll
    for (int db = 0; db < 2; ++db)
#pragma unroll
        for (int nb = 0; nb < 8; ++nb)
            { float* q = so + (size_t)(16 * nb + 4 * fq) * 256 + 32 * w + 16 * db + fr; asm volatile("" : "+v"(q));
#pragma unroll
              for (int e = 0; e < 4; ++e) q[e * 256] = sacc[db][nb][e]; }
}

__device__ __forceinline__ void phase_recur(CPARAMS p, unsigned char* lds) {
#ifndef NO_GLA_CHAIN
    for (int u = blockIdx.x; u < 240; u += gridDim.x) {
        if (u < 16) gla_chain(p, lds, u >> 2, u & 3);
        else if (u >= 48 && u < 112) gla_chain(p, lds, 4 + ((u - 48) >> 2), (u - 48) & 3);
        else continue;
        __syncthreads();
    }
#endif
    asm volatile("" ::: "memory");
#ifndef NO_GDN_CHAIN
    for (int u = blockIdx.x; u < 240; u += gridDim.x) {
        if (u >= 16 && u < 48) gdn_chain(p, lds, (u - 16) >> 3, (u - 16) & 7);
        else if (u >= 112) gdn_chain(p, lds, 4 + ((u - 112) >> 3), (u - 112) & 7);
        else continue;
        __syncthreads();
    }
#endif
}

__device__ __forceinline__ void phase_halo(CPARAMS p) {
    const float* headg = (const float*)(p.ws + WS_HEADG); const float* headv = (const float*)(p.ws + WS_HEADV); const float* tailg = (const float*)(p.ws + WS_TAILG);
    bf16_t* act = (bf16_t*)(p.ws + WS_ACT);
    for (int idx = blockIdx.x * 512 + threadIdx.x; idx < NCHUNK * DFF; idx += gridDim.x * 512) {
        const int sc = idx / DFF, ch = idx % DFF;
        const bool sample = sc >= 128, first = sample || ((sc & 31) == 0), lastc = sample || ((sc & 31) == 31);
        const int s = sample ? 4 + (sc - 128) : (sc >> 5);
        float gm2, gm1;
        if (!first) { gm2 = tailg[((size_t)(sc - 1) * 2 + 0) * DFF + ch]; gm1 = tailg[((size_t)(sc - 1) * 2 + 1) * DFF + ch]; }
        else if (sample) { gm2 = p.state_ffn_conv[(size_t)(s - 4) * 11264 + ch]; gm1 = p.state_ffn_conv[(size_t)(s - 4) * 11264 + DFF + ch]; }
        else { gm2 = 0.f; gm1 = 0.f; }
        const float g0 = headg[((size_t)sc * 2) * DFF + ch], g1 = headg[((size_t)sc * 2 + 1) * DFF + ch];
        const float v0 = headv[((size_t)sc * 2) * DFF + ch], v1 = headv[((size_t)sc * 2 + 1) * DFF + ch];
        const float w0 = p.ffn_conv_w[ch], w1 = p.ffn_conv_w[DFF + ch], w2 = p.ffn_conv_w[2 * DFF + ch], bb = p.ffn_conv_b[ch];
        act[(size_t)(sc * 64) * DFF + ch] = f2bf(siluf(w0 * gm2 + w1 * gm1 + w2 * g0 + bb) * v0);
        act[(size_t)(sc * 64 + 1) * DFF + ch] = f2bf(siluf(w0 * gm1 + w1 * g0 + w2 * g1 + bb) * v1);
        if (lastc) {
            float* of = p.out + (s < 4 ? OUT_P_FFN + (size_t)s * 11264 : OUT_S_FFN + (size_t)(s - 4) * 11264);
            of[ch] = tailg[((size_t)sc * 2) * DFF + ch]; of[DFF + ch] = tailg[((size_t)sc * 2 + 1) * DFF + ch];
        }
    }
}

constexpr int NPHASE = 11;
#ifdef ONLY_PHASE
#define PH_EN(n) ((n) == ONLY_PHASE)
#else
#define PH_EN(n) true
#endif
__global__ void __launch_bounds__(512) fwd_megakernel(Params p_) {
    typedef const __attribute__((address_space(4))) Params* KP;
    KP pp0 = (KP)__builtin_amdgcn_kernarg_segment_ptr();
    const int ph_lo_ = p_.ph_lo, ph_hi_ = p_.ph_hi;
#define p (*({ KP q_ = pp0; asm volatile("" : "+s"(q_)); q_; }))
    extern __shared__ __attribute__((aligned(16))) unsigned char shm[];
    cg::grid_group grid = cg::this_grid();
    const bool multi = (ph_hi_ - ph_lo_) > 1;
#define PH_ON(n) (PH_EN(n) && ph_lo_ <= (n) && (n) < ph_hi_)
#ifndef DUP_MASK
#define DUP_MASK 0
#endif
#define DUP_N(n) (((DUP_MASK) >> (n)) & 1 ? 2 : 1)
#define PH_SYNC(n) do { if (multi && (n) + 1 < ph_hi_ && (n) >= ph_lo_) { __threadfence(); grid.sync(); } } while (0)
    if (PH_ON(0)) phase_prep(p, shm);
#if (DUP_MASK >> 0) & 1
    __threadfence(); grid.sync();
    if (PH_ON(0)) phase_prep(p, shm);
#endif
    PH_SYNC(0);
    if (PH_ON(1)) norm_phase<0>(p, shm);
#if (DUP_MASK >> 1) & 1
    __threadfence(); grid.sync();
    if (PH_ON(1)) norm_phase<0>(p, shm);
#endif
    PH_SYNC(1);
    if (PH_ON(2)) { pg8::Gemm g{(const bf16_t*)(p.ws + WS_H1), (const bf16_t*)(p.ws + WS_WT_IN), T_ROWS, NPROJ, DM}; pg8::StaticOrder S; S.init(g.M, g.N, (int)gridDim.x, (int)blockIdx.x); pg8::EpiProj E{(bf16_t*)(p.ws + WS_PROJ), NPROJ}; pg8::gemm_phase((LAS unsigned char*)shm, g, S, E); }
#if (DUP_MASK >> 2) & 1
    __threadfence(); grid.sync();
    if (PH_ON(2)) { pg8::Gemm g{(const bf16_t*)(p.ws + WS_H1), (const bf16_t*)(p.ws + WS_WT_IN), T_ROWS, NPROJ, DM}; pg8::StaticOrder S; S.init(g.M, g.N, (int)gridDim.x, (int)blockIdx.x); pg8::EpiProj E{(bf16_t*)(p.ws + WS_PROJ), NPROJ}; pg8::gemm_phase((LAS unsigned char*)shm, g, S, E); }
#endif
    PH_SYNC(2);
    if (PH_ON(3)) phase_chunk_prep(p, shm);
#if (DUP_MASK >> 3) & 1
    __threadfence(); grid.sync();
    if (PH_ON(3)) phase_chunk_prep(p, shm);
#endif
    PH_SYNC(3);
    if (PH_ON(4)) phase_recur(p, shm);
#if (DUP_MASK >> 4) & 1
    __threadfence(); grid.sync();
    if (PH_ON(4)) phase_recur(p, shm);
#endif
    PH_SYNC(4);
    if (PH_ON(5)) { pg8::Gemm g{(const bf16_t*)(p.ws + WS_MIXO), (const bf16_t*)(p.ws + WS_WT_OUT), T_ROWS, DM, DM}; pg8::StaticOrder S; S.init(g.M, g.N, (int)gridDim.x, (int)blockIdx.x); pg8::EpiResid E{(float*)(p.ws + WS_X1), p.x_prompt, p.x_sample, (const float*)(p.ws + WS_MOD) + 4096}; pg8::gemm_phase((LAS unsigned char*)shm, g, S, E); }
#if (DUP_MASK >> 5) & 1
    __threadfence(); grid.sync();
    if (PH_ON(5)) { pg8::Gemm g{(const bf16_t*)(p.ws + WS_MIXO), (const bf16_t*)(p.ws + WS_WT_OUT), T_ROWS, DM, DM}; pg8::StaticOrder S; S.init(g.M, g.N, (int)gridDim.x, (int)blockIdx.x); pg8::EpiResid E{(float*)(p.ws + WS_X1), p.x_prompt, p.x_sample, (const float*)(p.ws + WS_MOD) + 4096}; pg8::gemm_phase((LAS unsigned char*)shm, g, S, E); }
#endif
    PH_SYNC(5);
    if (PH_ON(6)) norm_phase<1>(p, shm);
#if (DUP_MASK >> 6) & 1
    __threadfence(); grid.sync();
    if (PH_ON(6)) norm_phase<1>(p, shm);
#endif
    PH_SYNC(6);
    if (PH_ON(7)) { pg8::Gemm g{(const bf16_t*)(p.ws + WS_H2), (const bf16_t*)(p.ws + WS_WT_UP), T_ROWS, NUP, DM}; pg8::StaticOrder S; S.init(g.M, g.N, (int)gridDim.x, (int)blockIdx.x); pg8::EpiUp E{(bf16_t*)(p.ws + WS_ACT), p.ffn_conv_w, p.ffn_conv_b, (float*)(p.ws + WS_HEADG), (float*)(p.ws + WS_HEADV), (float*)(p.ws + WS_TAILG)}; pg8::gemm_phase((LAS unsigned char*)shm, g, S, E); }
#if (DUP_MASK >> 7) & 1
    __threadfence(); grid.sync();
    if (PH_ON(7)) { pg8::Gemm g{(const bf16_t*)(p.ws + WS_H2), (const bf16_t*)(p.ws + WS_WT_UP), T_ROWS, NUP, DM}; pg8::StaticOrder S; S.init(g.M, g.N, (int)gridDim.x, (int)blockIdx.x); pg8::EpiUp E{(bf16_t*)(p.ws + WS_ACT), p.ffn_conv_w, p.ffn_conv_b, (float*)(p.ws + WS_HEADG), (float*)(p.ws + WS_HEADV), (float*)(p.ws + WS_TAILG)}; pg8::gemm_phase((LAS unsigned char*)shm, g, S, E); }
#endif
    PH_SYNC(7);
    if (PH_ON(8)) phase_halo(p);
#if (DUP_MASK >> 8) & 1
    __threadfence(); grid.sync();
    if (PH_ON(8)) phase_halo(p);
#endif
    PH_SYNC(8);
    if (PH_ON(9)) { pg8::Gemm g{(const bf16_t*)(p.ws + WS_ACT), (const bf16_t*)(p.ws + WS_WT_DOWN), T_ROWS, DM, DFF}; pg8::StaticOrder S; S.init(g.M, g.N, (int)gridDim.x, (int)blockIdx.x); pg8::EpiResid E{(float*)(p.ws + WS_X1), (const float*)(p.ws + WS_X1), nullptr, (const float*)(p.ws + WS_MOD) + 10240}; pg8::gemm_phase((LAS unsigned char*)shm, g, S, E); }
#if (DUP_MASK >> 9) & 1
    __threadfence(); grid.sync();
    if (PH_ON(9)) { pg8::Gemm g{(const bf16_t*)(p.ws + WS_ACT), (const bf16_t*)(p.ws + WS_WT_DOWN), T_ROWS, DM, DFF}; pg8::StaticOrder S; S.init(g.M, g.N, (int)gridDim.x, (int)blockIdx.x); pg8::EpiResid E{(float*)(p.ws + WS_X1), (const float*)(p.ws + WS_X1), nullptr, (const float*)(p.ws + WS_MOD) + 10240}; pg8::gemm_phase((LAS unsigned char*)shm, g, S, E); }
#endif
    PH_SYNC(9);
    if (PH_ON(10)) norm_phase<2>(p, shm);
#if (DUP_MASK >> 10) & 1
    __threadfence(); grid.sync();
    if (PH_ON(10)) norm_phase<2>(p, shm);
#endif
#undef p
}


#ifdef DBG_STOP
__global__ void dbg_digest(const unsigned short* ws16, size_t L, float* out, size_t n) {
    for (size_t i = (size_t)blockIdx.x * blockDim.x + threadIdx.x; i < n; i += (size_t)gridDim.x * blockDim.x) {
        unsigned sum = 0; for (size_t j = i; j < L; j += n) sum += ws16[j];
        out[i] = (float)sum;
    }
}
#endif
#ifndef MK_MULTI_LAUNCH
#define MK_MULTI_LAUNCH 0
#endif

extern "C" void kernel_launch(void* const* d_in, const int* in_sizes, int n_in, void* d_out, int out_size, void* d_ws, size_t ws_size, hipStream_t stream) {
    static int grid_blocks = 0;
    if (grid_blocks == 0) {
        if (n_in != 26 || (size_t)out_size != OUT_TOTAL || ws_size < WS_END) {
            fprintf(stderr, "kernel_launch: unexpected shapes: n_in %d out %d ws %zu (need %zu); nothing launched\n", n_in, out_size, ws_size, (size_t)WS_END); grid_blocks = -1; return; }
        int dev = 0, cus = 0, per_cu = 0;
        hipGetDevice(&dev);
        hipDeviceGetAttribute(&cus, hipDeviceAttributeMultiprocessorCount, dev);
        if (hipFuncSetAttribute((const void*)fwd_megakernel, hipFuncAttributeMaxDynamicSharedMemorySize, LDS_BYTES) != hipSuccess) { fprintf(stderr, "kernel_launch: hipFuncSetAttribute failed\n"); grid_blocks = -1; return; }
        if (hipOccupancyMaxActiveBlocksPerMultiprocessor(&per_cu, (const void*)fwd_megakernel, 512, LDS_BYTES) != hipSuccess || per_cu < 1) { fprintf(stderr, "kernel_launch: occupancy query failed (%d)\n", per_cu); grid_blocks = -1; return; }
        grid_blocks = cus * per_cu;
    }
    if (grid_blocks < 0) return;
    Params p{};
    const float** pp = (const float**)&p;
    for (int i = 0; i < 26; ++i) pp[i] = (const float*)d_in[i];
    p.out = (float*)d_out; p.ws = (unsigned char*)d_ws;
#if MK_MULTI_LAUNCH
#ifdef DBG_STOP
    for (int ph = 0; ph <= DBG_STOP; ++ph) { p.ph_lo = ph; p.ph_hi = ph + 1; hipLaunchKernelGGL(fwd_megakernel, dim3(grid_blocks), dim3(512), LDS_BYTES, stream, p); }
    hipLaunchKernelGGL(dbg_digest, dim3(2048), dim3(256), 0, stream, (const unsigned short*)d_ws, (size_t)(WS_END / 2), (float*)d_out, (size_t)OUT_TOTAL);
#else
    for (int ph = 0; ph < NPHASE; ++ph) { p.ph_lo = ph; p.ph_hi = ph + 1; hipLaunchKernelGGL(fwd_megakernel, dim3(grid_blocks), dim3(512), LDS_BYTES, stream, p); }
#endif
#else
    p.ph_lo = 0; p.ph_hi = NPHASE;
    void* args[] = {&p};
    hipError_t e = hipLaunchCooperativeKernel((void*)fwd_megakernel, dim3(grid_blocks), dim3(512), args, LDS_BYTES, stream);
    if (e != hipSuccess) fprintf(stderr, "cooperative launch failed: %s (grid %d)\n", hipGetErrorString(e), grid_blocks);
#endif
}
```

```cpp
#include <hip/hip_runtime.h>
#include <hip/hip_cooperative_groups.h>
#include <cstdio>
namespace cg = cooperative_groups;

#define LAS __attribute__((address_space(3)))
typedef unsigned short bf16_t;
typedef short bf16x8 __attribute__((ext_vector_type(8)));
typedef float f32x4 __attribute__((ext_vector_type(4)));
typedef unsigned u32x4 __attribute__((ext_vector_type(4)));
typedef unsigned u32x2 __attribute__((ext_vector_type(2)));

constexpr int T_ROWS = 9216, DM = 2048, NPROJ = 7168, DFF = 5632, NUP = 11264, NSEQ = 20, NCHUNK = 144;
constexpr int PC_GLA_Q = 0, PC_GLA_K = 512, PC_GLA_V = 1024, PC_GLA_R = 2048, PC_GDN_Q = 3072, PC_GDN_K = 4096, PC_GDN_V = 5120, PC_GDN_G = 6144;
constexpr int W_IN_LD = 7200;
constexpr size_t OUT_Y = 0, OUT_P_GLA = 18874368, OUT_P_GDN = 19398656, OUT_P_CONV = 19922944, OUT_P_FFN = 19959808,
                 OUT_S_GLA = 20004864, OUT_S_GDN = 22102016, OUT_S_CONV = 24199168, OUT_S_FFN = 24346624, OUT_TOTAL = 24526848;
constexpr size_t MiB = 1u << 20;
constexpr size_t WS_WT_OUT = 0, WS_WT_UP = 8 * MiB, WS_WT_DOWN = 52 * MiB, WS_MIXO = 74 * MiB, WS_PROJ = 110 * MiB, WS_X1 = 110 * MiB, WS_H2 = 182 * MiB,
                 WS_WT_IN = 236 * MiB, WS_H1 = 264 * MiB, WS_OPS = 236 * MiB, WS_ACT = 236 * MiB, WS_SMALL = 358 * MiB;
constexpr size_t WS_MOD = WS_SMALL, WS_PSMALL = WS_SMALL + 1 * MiB, WS_WT_SMALL = WS_PSMALL + 1280 * 1024, WS_GLAST = WS_WT_SMALL + 128 * 1024,
                 WS_HEADG = WS_GLAST + 1 * MiB, WS_HEADV = WS_HEADG + 6553600, WS_TAILG = WS_HEADV + 6553600, WS_END = WS_TAILG + 6553600;
constexpr size_t OPS_UNIT = 73728;
constexpr int LDS_BYTES = 155648;
constexpr float EPSF = 1e-6f;

struct Params;
#define CPARAMS const __attribute__((address_space(4))) Params&
struct Params {
    const float *x_prompt, *x_sample, *c_prompt, *c_sample, *state_gla, *state_gdn, *state_gdn_conv, *state_ffn_conv, *w_ada, *b_ada, *norm1, *w_in, *gla_wg, *gla_bg,
        *gla_norm, *gdn_conv_w, *gdn_a_log, *gdn_dt_bias, *gdn_norm, *w_out, *norm2, *w_up, *ffn_conv_w, *ffn_conv_b, *w_down, *final_norm;
    float* out; unsigned char* ws; int ph_lo, ph_hi;
};

typedef float f32x2v __attribute__((ext_vector_type(2)));
typedef __bf16 bf16x2v __attribute__((ext_vector_type(2)));
__device__ __forceinline__ unsigned cvt_pk_bf16(float lo, float hi) { f32x2v v = {lo, hi}; bf16x2v b = __builtin_convertvector(v, bf16x2v); unsigned r; __builtin_memcpy(&r, &b, 4); return r; }
__device__ __forceinline__ bf16_t f2bf(float f) { return (bf16_t)(cvt_pk_bf16(f, 0.f) & 0xffffu); }
__device__ __forceinline__ float bf2f(bf16_t b) { return __uint_as_float(((unsigned)b) << 16); }
__device__ __forceinline__ float bflo(unsigned u) { return __uint_as_float(u << 16); }
__device__ __forceinline__ float bfhi(unsigned u) { return __uint_as_float(u & 0xffff0000u); }
__device__ __forceinline__ float siluf(float x) { return x / (1.f + __expf(-x)); }
__device__ __forceinline__ int seq_of_row(int r) { return r < 8192 ? (r >> 11) : 4 + ((r - 8192) >> 6); }
__device__ __forceinline__ const float* xrow(CPARAMS p, int r) { return r < 8192 ? p.x_prompt + (size_t)r * DM : p.x_sample + (size_t)(r - 8192) * DM; }
__device__ __forceinline__ f32x4 mfma16(bf16x8 a, bf16x8 b, f32x4 c) { return __builtin_amdgcn_mfma_f32_16x16x32_bf16(a, b, c, 0, 0, 0); }
__device__ __forceinline__ bf16x8 ldfrag(const bf16_t* base, int row, int ld, int k) { return *(const bf16x8*)(base + row * ld + k); }

__device__ __forceinline__ void gemv_unit(CPARAMS p, unsigned char* lds, int u) {
    const int tid = threadIdx.x, w = tid >> 6, lane = tid & 63;
    float* tab = (float*)lds;
    float* red = (float*)(lds + 40960);
    float* mod = (float*)(p.ws + WS_MOD);
    const int col4 = 256 * u + 4 * lane;
    float acc[NSEQ][4];
#pragma unroll
    for (int s = 0; s < NSEQ; ++s) { acc[s][0] = 0.f; acc[s][1] = 0.f; acc[s][2] = 0.f; acc[s][3] = 0.f; }
    for (int sub = 0; sub < 4; ++sub) {
        const int k0 = w * 256 + sub * 64;
        __syncthreads();
#pragma unroll
        for (int s = 0; s < NSEQ; ++s) { const float c = (s < 4) ? p.c_prompt[s * DM + k0 + lane] : p.c_sample[(s - 4) * DM + k0 + lane]; tab[(w * NSEQ + s) * 64 + lane] = siluf(c); }
        __syncthreads();
        for (int k = 0; k < 64; k += 8) {
            float4 wv[8];
            const float* wp = p.w_ada + (size_t)(k0 + k) * 12288 + col4;
#pragma unroll
            for (int i = 0; i < 8; ++i) { asm volatile("" : "+v"(wp)); wv[i] = *(const float4*)wp; wp += 12288; }
#pragma unroll
            for (int kk = 0; kk < 8; kk += 4) {
#pragma unroll
                for (int s = 0; s < NSEQ; ++s) {
                    const float4 t = *(const float4*)&tab[(w * NSEQ + s) * 64 + k + kk];
                    acc[s][0] += t.x * wv[kk].x + t.y * wv[kk + 1].x + t.z * wv[kk + 2].x + t.w * wv[kk + 3].x;
                    acc[s][1] += t.x * wv[kk].y + t.y * wv[kk + 1].y + t.z * wv[kk + 2].y + t.w * wv[kk + 3].y;
                    acc[s][2] += t.x * wv[kk].z + t.y * wv[kk + 1].z + t.z * wv[kk + 2].z + t.w * wv[kk + 3].z;
                    acc[s][3] += t.x * wv[kk].w + t.y * wv[kk + 1].w + t.z * wv[kk + 2].w + t.w * wv[kk + 3].w;
                }
            }
        }
    }
    for (int w2 = 0; w2 < 8; ++w2) {
        if (w == w2) {
#pragma unroll
            for (int s = 0; s < NSEQ; ++s) {
                float4* q = (float4*)&red[s * 256 + 4 * lane];
                float4 v; if (w2 == 0) v = make_float4(0.f, 0.f, 0.f, 0.f); else v = *q;
                v.x += acc[s][0]; v.y += acc[s][1]; v.z += acc[s][2]; v.w += acc[s][3]; *q = v;
            }
        }
        __syncthreads();
    }
    for (int idx = tid; idx < NSEQ * 256; idx += 512) { const int s = idx >> 8, c = idx & 255; mod[s * 12288 + 256 * u + c] = red[idx] + p.b_ada[256 * u + c]; }
    __syncthreads();
}

constexpr int NCVT_IN = 1792, NCVT_SMALL = 16, NCVT_OUT = 512, NCVT_UP = 2816, NCVT_DOWN = 1408, NCVT = NCVT_IN + NCVT_SMALL + NCVT_OUT + NCVT_UP + NCVT_DOWN;
#define CVT_DESC(j_, src, dst, ld, k0, K, scol0, small) do { int jj_ = (j_); small = false; \
    if (jj_ < NCVT_IN) { const int nt = jj_ >> 4, kt = jj_ & 15; const int n0 = nt * 64; src = p.w_in; ld = W_IN_LD; k0 = kt * 128; dst = (bf16_t*)(p.ws + WS_WT_IN) + (size_t)n0 * DM; K = DM; scol0 = n0 < 3072 ? n0 : n0 + 16; } \
    else if ((jj_ -= NCVT_IN) < NCVT_SMALL) { src = p.w_in; ld = W_IN_LD; k0 = jj_ * 128; dst = (bf16_t*)(p.ws + WS_WT_SMALL); K = DM; scol0 = 0; small = true; } \
    else if ((jj_ -= NCVT_SMALL) < NCVT_OUT) { const int nt = jj_ >> 4, kt = jj_ & 15; src = p.w_out; ld = DM; k0 = kt * 128; dst = (bf16_t*)(p.ws + WS_WT_OUT) + (size_t)(nt * 64) * DM; K = DM; scol0 = nt * 64; } \
    else if ((jj_ -= NCVT_OUT) < NCVT_UP) { const int nt = jj_ >> 4, kt = jj_ & 15; const int pn = nt >> 2, bj = (nt >> 1) & 1, cc0 = (nt & 1) * 64; src = p.w_up; ld = NUP; k0 = kt * 128; dst = (bf16_t*)(p.ws + WS_WT_UP) + (size_t)(nt * 64) * DM; K = DM; scol0 = bj * DFF + pn * 128 + cc0; } \
    else { jj_ -= NCVT_UP; const int nt = jj_ / 44, kt = jj_ % 44; src = p.w_down; ld = DM; k0 = kt * 128; dst = (bf16_t*)(p.ws + WS_WT_DOWN) + (size_t)(nt * 64) * DFF; K = DFF; scol0 = nt * 64; } } while (0)
#define CVT_LOAD(src, ld, k0, scol0, small, v0, v1, v2, v3) do { const int c4_ = (threadIdx.x & 15) * 4; int scol_ = scol0 + c4_; bool valid_ = true; \
    if (small) { valid_ = c4_ < 32; scol_ = (c4_ < 16) ? (3072 + c4_) : (7184 + c4_ - 16); } \
    const int kp0_ = (threadIdx.x >> 4), kp1_ = kp0_ + 32; v0 = make_float4(0.f, 0.f, 0.f, 0.f); v1 = v0; v2 = v0; v3 = v0; \
    if (valid_) { v0 = *(const float4*)(src + (size_t)(k0 + 2 * kp0_) * ld + scol_); v1 = *(const float4*)(src + (size_t)(k0 + 2 * kp0_ + 1) * ld + scol_); \
                  v2 = *(const float4*)(src + (size_t)(k0 + 2 * kp1_) * ld + scol_); v3 = *(const float4*)(src + (size_t)(k0 + 2 * kp1_ + 1) * ld + scol_); } } while (0)
__device__ __forceinline__ void cvt_store(unsigned char* lds, bf16_t* dst, int k0, int K, bool small, float4 a0, float4 b0, float4 a1, float4 b1) {
    const int tid = threadIdx.x, c4 = (tid & 15) * 4;
    unsigned* Tl = (unsigned*)lds;
    { const int kp = (tid >> 4);
      Tl[(c4 + 0) * 65 + kp] = cvt_pk_bf16(a0.x, b0.x); Tl[(c4 + 1) * 65 + kp] = cvt_pk_bf16(a0.y, b0.y); Tl[(c4 + 2) * 65 + kp] = cvt_pk_bf16(a0.z, b0.z); Tl[(c4 + 3) * 65 + kp] = cvt_pk_bf16(a0.w, b0.w); }
    { const int kp = (tid >> 4) + 32;
      Tl[(c4 + 0) * 65 + kp] = cvt_pk_bf16(a1.x, b1.x); Tl[(c4 + 1) * 65 + kp] = cvt_pk_bf16(a1.y, b1.y); Tl[(c4 + 2) * 65 + kp] = cvt_pk_bf16(a1.z, b1.z); Tl[(c4 + 3) * 65 + kp] = cvt_pk_bf16(a1.w, b1.w); }
    __syncthreads();
    {
        const int n = tid >> 3, seg = tid & 7;
        u32x4 o0, o1;
        o0.x = Tl[n * 65 + seg * 8 + 0]; o0.y = Tl[n * 65 + seg * 8 + 1]; o0.z = Tl[n * 65 + seg * 8 + 2]; o0.w = Tl[n * 65 + seg * 8 + 3];
        o1.x = Tl[n * 65 + seg * 8 + 4]; o1.y = Tl[n * 65 + seg * 8 + 5]; o1.z = Tl[n * 65 + seg * 8 + 6]; o1.w = Tl[n * 65 + seg * 8 + 7];
        if (!small || n < 32) { u32x4* q = (u32x4*)(dst + (size_t)n * K + k0 + seg * 16); q[0] = o0; q[1] = o1; }
    }
    __syncthreads();
}
__device__ __forceinline__ void cvt_range(CPARAMS p, unsigned char* lds, int j0, int stride) {
    if (j0 >= NCVT) return;
    const float* srcc; bf16_t* dstc; int ldc, k0c, Kc, scc; bool smc; float4 c0, c1, c2, c3;
    CVT_DESC(j0, srcc, dstc, ldc, k0c, Kc, scc, smc);
    CVT_LOAD(srcc, ldc, k0c, scc, smc, c0, c1, c2, c3);
    for (int j = j0; j < NCVT; j += stride) {
        const float* srcn = srcc; bf16_t* dstn = dstc; int ldn = ldc, k0n = k0c, Kn = Kc, scn = scc; bool smn = smc; float4 n0 = c0, n1 = c1, n2 = c2, n3 = c3;
        if (j + stride < NCVT) { CVT_DESC(j + stride, srcn, dstn, ldn, k0n, Kn, scn, smn); CVT_LOAD(srcn, ldn, k0n, scn, smn, n0, n1, n2, n3); }
        cvt_store(lds, dstc, k0c, Kc, smc, c0, c1, c2, c3);
        srcc = srcn; dstc = dstn; ldc = ldn; k0c = k0n; Kc = Kn; scc = scn; smc = smn; c0 = n0; c1 = n1; c2 = n2; c3 = n3;
    }
}

__device__ __forceinline__ void phase_prep(CPARAMS p, unsigned char* lds) {
    const int G = gridDim.x, b = blockIdx.x;
    if (G >= 96) {
        if (b < 48) gemv_unit(p, lds, b);
        else cvt_range(p, lds, b - 48, G - 48);
    } else {
        for (int u = b; u < 48; u += G) gemv_unit(p, lds, u);
        cvt_range(p, lds, b, G);
    }
}

template <int MODE> __device__ __forceinline__ void norm_phase(CPARAMS p, unsigned char* lds) {
    const int tid = threadIdx.x, w = tid >> 6, lane = tid & 63, fr = lane & 15, fq = lane >> 4;
    float* cA = (float*)lds; float* cB = cA + 2048; float* red = cB + 2048; float* part = red + 128;
    const float* mod = (const float*)(p.ws + WS_MOD);
    bf16x8 bw[2][8];
    if (MODE == 0) {
        const bf16_t* wts = (const bf16_t*)(p.ws + WS_WT_SMALL);
#pragma unroll
        for (int nb = 0; nb < 2; ++nb)
#pragma unroll
            for (int ks = 0; ks < 8; ++ks) bw[nb][ks] = *(const bf16x8*)(wts + (size_t)(16 * nb + fr) * DM + 256 * w + 32 * ks + 8 * fq);
    }
    int cur_s = -1;
    for (int u = blockIdx.x; u < T_ROWS / 16; u += gridDim.x) {
        const int row0 = 16 * u, s = seq_of_row(row0);
        if (s != cur_s) {
            __syncthreads();
            for (int k = tid; k < DM; k += 512) {
                float a, b;
                if (MODE == 0) { a = p.norm1[k] * (1.f + mod[s * 12288 + 2048 + k]); b = mod[s * 12288 + k]; }
                else if (MODE == 1) { a = p.norm2[k] * (1.f + mod[s * 12288 + 8192 + k]); b = mod[s * 12288 + 6144 + k]; }
                else { a = p.final_norm[k]; b = 0.f; }
                cA[k] = a; cB[k] = b;
            }
            cur_s = s;
            __syncthreads();
        }
        const int row = row0 + fr;
        const float* src = (MODE == 0) ? xrow(p, row) : (const float*)(p.ws + WS_X1) + (size_t)row * DM;
        float4 xv[8][2];
        float ss = 0.f;
#pragma unroll
        for (int ks = 0; ks < 8; ++ks) {
            const float4* q = (const float4*)(src + 256 * w + 32 * ks + 8 * fq);
            xv[ks][0] = q[0]; xv[ks][1] = q[1];
            ss += xv[ks][0].x * xv[ks][0].x + xv[ks][0].y * xv[ks][0].y + xv[ks][0].z * xv[ks][0].z + xv[ks][0].w * xv[ks][0].w;
            ss += xv[ks][1].x * xv[ks][1].x + xv[ks][1].y * xv[ks][1].y + xv[ks][1].z * xv[ks][1].z + xv[ks][1].w * xv[ks][1].w;
        }
        ss += __shfl_xor(ss, 16); ss += __shfl_xor(ss, 32);
        if (fq == 0) red[w * 16 + fr] = ss;
        __syncthreads();
        float tot = 0.f;
#pragma unroll
        for (int i = 0; i < 8; ++i) tot += red[i * 16 + fr];
        const float rstd = rsqrtf(tot * (1.f / 2048.f) + EPSF);
        int drow = row;
        if (MODE == 1) { const int tt = row & 255, k8 = tt & 7, l16 = tt >> 3; drow = (row & ~255) + 128 * (k8 >> 2) + 64 * (l16 >> 4) + 16 * (k8 & 3) + (l16 & 15); }
        f32x4 acc0 = {0.f, 0.f, 0.f, 0.f}, acc1 = {0.f, 0.f, 0.f, 0.f};
#pragma unroll
        for (int ks = 0; ks < 8; ++ks) {
            const int k = 256 * w + 32 * ks + 8 * fq;
            const float4 a0 = *(const float4*)&cA[k], a1 = *(const float4*)&cA[k + 4], b0 = *(const float4*)&cB[k], b1 = *(const float4*)&cB[k + 4];
            float4 h0, h1;
            h0.x = xv[ks][0].x * rstd * a0.x + b0.x; h0.y = xv[ks][0].y * rstd * a0.y + b0.y; h0.z = xv[ks][0].z * rstd * a0.z + b0.z; h0.w = xv[ks][0].w * rstd * a0.w + b0.w;
            h1.x = xv[ks][1].x * rstd * a1.x + b1.x; h1.y = xv[ks][1].y * rstd * a1.y + b1.y; h1.z = xv[ks][1].z * rstd * a1.z + b1.z; h1.w = xv[ks][1].w * rstd * a1.w + b1.w;
            if (MODE == 2) { float4* o = (float4*)(p.out + OUT_Y + (size_t)row * DM + k); o[0] = h0; o[1] = h1; }
            else {
                u32x4 pk; pk.x = cvt_pk_bf16(h0.x, h0.y); pk.y = cvt_pk_bf16(h0.z, h0.w); pk.z = cvt_pk_bf16(h1.x, h1.y); pk.w = cvt_pk_bf16(h1.z, h1.w);
                bf16_t* hb = (bf16_t*)(p.ws + (MODE == 0 ? WS_H1 : WS_H2));
                *(u32x4*)(hb + (size_t)drow * DM + k) = pk;
                if (MODE == 0) { bf16x8 af; __builtin_memcpy(&af, &pk, 16); acc0 = mfma16(af, bw[0][ks], acc0); acc1 = mfma16(af, bw[1][ks], acc1); }
            }
        }
        if (MODE == 0) {
#pragma unroll
            for (int e = 0; e < 4; ++e) { part[(w * 16 + 4 * fq + e) * 32 + fr] = acc0[e]; part[(w * 16 + 4 * fq + e) * 32 + 16 + fr] = acc1[e]; }
            __syncthreads();
            const int r = tid >> 5, c = tid & 31; float sum = 0.f;
#pragma unroll
            for (int i = 0; i < 8; ++i) sum += part[(i * 16 + r) * 32 + c];
            ((float*)(p.ws + WS_PSMALL))[(size_t)(row0 + r) * 32 + c] = sum;
        }
        __syncthreads();
    }
}

namespace pg8 {
constexpr int BM = 256, BK = 64, HALF = 128, HTB = HALF * BK * 2, STAGE_BYTES = 8 * HTB, NXCD = 8, WGM = 8;
__device__ __forceinline__ int lds_byte(int r, int c) { const int st = (r >> 4) * 2 + (c >> 5), rr = r & 15, cc = c & 31, ob = rr * 64 + cc * 2; return st * 1024 + (ob ^ (((ob >> 9) & 1) << 5)); }
__device__ __forceinline__ void stage_rc(int b, int& R, int& C) { const int st = b / 1024, sb = b % 1024, swz = sb ^ (((sb >> 9) & 1) << 5); R = (st >> 1) * 16 + swz / 64; C = (st & 1) * 32 + (swz % 64) / 2; }
__device__ __forceinline__ int perm32(int rho) { const int n = rho >> 4, i = rho & 15; return 8 * (i >> 2) + 4 * n + (i & 3); }
struct Unit { int pm, pn, kofs, nt, part; };
struct Gemm { const bf16_t* A; const bf16_t* Bt; int M, N, K; };
struct StaticOrder {
    int nM, nN, nwg, G, c, K, S, nfull;
    __device__ void init(int M, int N, int G_, int c_, int K_ = 0, int S_ = 0) { nM = M / BM; nN = N / BM; nwg = nM * nN; G = G_; c = c_; K = K_; S = S_; nfull = (S_ > 0) ? (nwg / G_) * G_ : nwg; }
    __device__ bool next(int i, Unit& u) const {
        const long V = (long)i * G + c;
        long L;
        if (V < nfull) { L = V; u.kofs = 0; u.nt = K / BK; u.part = 0; }
        else { if (S <= 0) return false; const long r = V - nfull; L = nfull + r / S; if (L >= nwg) return false; const int piece = (int)(r % S); u.kofs = piece * (K / S) * 2; u.nt = (K / S) / BK; u.part = 1; }
        int wgid = (int)L; { const int q = nwg / NXCD, r = nwg % NXCD, xcd = wgid % NXCD, off = wgid / NXCD; wgid = (xcd < r ? xcd * (q + 1) : r * (q + 1) + (xcd - r) * q) + off; }
        const int nig = WGM * nN, gid = wgid / nig, fm = gid * WGM, gsz = (nM - fm) < WGM ? (nM - fm) : WGM;
        u.pm = fm + ((wgid % nig) % gsz); u.pn = (wgid % nig) / gsz; return true;
    }
};

template <class Epi>
__device__ __forceinline__ void gemm_phase(LAS unsigned char* lds, const Gemm g, const StaticOrder& S, const Epi& E) {
    const int tid = threadIdx.x, wid = __builtin_amdgcn_readfirstlane(tid >> 6), lane = tid & 63, wr = wid >> 2, wc = wid & 3, fr = lane & 15, fq = lane >> 4;
    const int K = g.K;
    unsigned voffA[2], voffB[2];
#pragma unroll
    for (int i = 0; i < 2; ++i) { int R, C; stage_rc(tid * 16 + i * 8192, R, C); const int Rb = Epi::PERM ? ((R & ~31) + perm32(R & 31)) : R;
        voffA[i] = (unsigned)(R * K + C) * 2u; voffB[i] = (unsigned)(Rb * K + C) * 2u; }
    const size_t kstep = (size_t)(BK * 2);
    const size_t hstep = (size_t)HALF * K * 2;
    const size_t tstep = 2 * hstep;
    const unsigned ldsw = (unsigned)wid * 1024u;
    const int aoff = lds_byte(wr * 64 + fr, fq * 8), boff = lds_byte(wc * 32 + fr, fq * 8);
#define PG8_SA(b, h) (((b) * 2 + (h)) * HTB)
#define PG8_SB(b, h) ((4 + (b) * 2 + (h)) * HTB)
#define PG8_STAGE(bufoff, gbase, voff) do { _Pragma("unroll") for (int _i = 0; _i < 2; ++_i) \
        __builtin_amdgcn_global_load_lds((const unsigned*)((const char*)(gbase) + (voff)[_i]), (LAS unsigned*)(lds + (bufoff) + ldsw + _i * 8192), 16, 0, 0); } while (0)
#define PG8_LDA(dst, b, h) do { _Pragma("unroll") for (int m = 0; m < 4; ++m) _Pragma("unroll") for (int k = 0; k < 2; ++k) dst[m][k] = *(const LAS bf16x8*)(lds + PG8_SA(b, h) + aoff + m * 2048 + k * 1024); } while (0)
#define PG8_LDB(dst, b, h) do { _Pragma("unroll") for (int n = 0; n < 2; ++n) _Pragma("unroll") for (int k = 0; k < 2; ++k) dst[n][k] = *(const LAS bf16x8*)(lds + PG8_SB(b, h) + boff + n * 2048 + k * 1024); } while (0)
#define PG8_MMA(ai, bj, At, Bt) do { __builtin_amdgcn_s_setprio(1); _Pragma("unroll") for (int m = 0; m < 4; ++m) _Pragma("unroll") for (int n = 0; n < 2; ++n) _Pragma("unroll") for (int k = 0; k < 2; ++k) \
        acc[ai][bj][m][n] = __builtin_amdgcn_mfma_f32_16x16x32_bf16(Bt[n][k], At[m][k], acc[ai][bj][m][n], 0, 0, 0); __builtin_amdgcn_s_setprio(0); } while (0)
#define PG8_WAIT_V(n) asm volatile("s_waitcnt vmcnt(" #n ")" ::: "memory")
#define PG8_WAIT_L(n) asm volatile("s_waitcnt lgkmcnt(" #n ")" ::: "memory")
#define PG8_BAR __builtin_amdgcn_s_barrier()
#define PG8_SCHED __builtin_amdgcn_sched_barrier(0)
    Unit cur, nxt; int ui = 0;
    if (!S.next(0, cur)) return;
    f32x4 acc[2][2][4][2];
#pragma unroll
    for (int a = 0; a < 2; ++a)
#pragma unroll
        for (int b = 0; b < 2; ++b)
#pragma unroll
            for (int m = 0; m < 4; ++m)
#pragma unroll
                for (int n = 0; n < 2; ++n) acc[a][b][m][n] = (f32x4){0.f, 0.f, 0.f, 0.f};
    bf16x8 At[4][2], B0[2][2], B1[2][2];
    const char* cA = (const char*)g.A + (size_t)cur.pm * tstep + cur.kofs; const char* cB = (const char*)g.Bt + (size_t)cur.pn * tstep + cur.kofs;
    PG8_STAGE(PG8_SB(0, 0), cB, voffB); PG8_STAGE(PG8_SA(0, 0), cA, voffA); PG8_STAGE(PG8_SB(0, 1), cB + hstep, voffB); PG8_STAGE(PG8_SA(0, 1), cA + hstep, voffA);
    if (wr == 1) PG8_BAR;
    PG8_WAIT_V(4); PG8_BAR;
    PG8_STAGE(PG8_SB(1, 0), cB + kstep, voffB); PG8_STAGE(PG8_SA(1, 0), cA + kstep, voffA); PG8_STAGE(PG8_SB(1, 1), cB + hstep + kstep, voffB);
    PG8_WAIT_V(6); PG8_BAR;
    for (;;) {
        const bool has_next = S.next(ui + 1, nxt);
        const char* nA = has_next ? (const char*)g.A + (size_t)nxt.pm * tstep + nxt.kofs : cA; const char* nB = has_next ? (const char*)g.Bt + (size_t)nxt.pn * tstep + nxt.kofs : cB;
        const int nt = cur.nt;
        for (int t = 0; t < nt; t += 2) {
            const bool last = (t == nt - 2);
            const char* a1 = cA + (size_t)(t + 1) * kstep;
            const char* a2 = last ? nA : cA + (size_t)(t + 2) * kstep; const char* b2 = last ? nB : cB + (size_t)(t + 2) * kstep;
            const char* a3 = a2 + kstep; const char* b3 = b2 + kstep;
            PG8_LDB(B0, 0, 0); PG8_SCHED; PG8_LDA(At, 0, 0); PG8_STAGE(PG8_SA(1, 1), a1 + hstep, voffA);
            PG8_WAIT_L(8); PG8_BAR; PG8_WAIT_L(0); PG8_MMA(0, 0, At, B0); PG8_BAR; PG8_SCHED;
            PG8_LDB(B1, 0, 1); PG8_STAGE(PG8_SB(0, 0), b2, voffB);
            PG8_BAR; PG8_WAIT_L(0); PG8_MMA(0, 1, At, B1); PG8_BAR;
            PG8_LDA(At, 0, 1); PG8_STAGE(PG8_SA(0, 0), a2, voffA);
            PG8_BAR; PG8_WAIT_L(0); PG8_MMA(1, 0, At, B0); PG8_BAR; PG8_SCHED;
            PG8_STAGE(PG8_SB(0, 1), b2 + hstep, voffB);
            PG8_WAIT_V(6); PG8_BAR; PG8_MMA(1, 1, At, B1); PG8_BAR;
            PG8_LDB(B0, 1, 0); PG8_SCHED; PG8_LDA(At, 1, 0); PG8_STAGE(PG8_SA(0, 1), a2 + hstep, voffA);
            PG8_WAIT_L(8); PG8_BAR; PG8_WAIT_L(0); PG8_MMA(0, 0, At, B0); PG8_BAR; PG8_SCHED;
            PG8_LDB(B1, 1, 1); PG8_STAGE(PG8_SB(1, 0), b3, voffB);
            PG8_BAR; PG8_WAIT_L(0); PG8_MMA(0, 1, At, B1); PG8_BAR;
            PG8_LDA(At, 1, 1); PG8_STAGE(PG8_SA(1, 0), a3, voffA);
            PG8_BAR; PG8_WAIT_L(0); PG8_MMA(1, 0, At, B0); PG8_BAR; PG8_SCHED;
            PG8_STAGE(PG8_SB(1, 1), b3 + hstep, voffB);
            PG8_WAIT_V(6); PG8_BAR; PG8_MMA(1, 1, At, B1); PG8_BAR;
        }
        E(acc, cur, wr, wc, fr, fq);
        if (!has_next) break;
#pragma unroll
        for (int a = 0; a < 2; ++a)
#pragma unroll
            for (int b = 0; b < 2; ++b)
#pragma unroll
                for (int m = 0; m < 4; ++m)
#pragma unroll
                    for (int n = 0; n < 2; ++n) acc[a][b][m][n] = (f32x4){0.f, 0.f, 0.f, 0.f};
        cur = nxt; cA = nA; cB = nB; ++ui;
    }
    PG8_WAIT_V(0);
    if (wr == 0) PG8_BAR;
    PG8_BAR;
#undef PG8_SA
#undef PG8_SB
#undef PG8_STAGE
#undef PG8_LDA
#undef PG8_LDB
#undef PG8_MMA
#undef PG8_WAIT_V
#undef PG8_WAIT_L
#undef PG8_BAR
#undef PG8_SCHED
}

struct EpiProj {
    static constexpr bool PERM = true;
    bf16_t* O; int ldc;
    __device__ __forceinline__ void operator()(const f32x4 (&acc)[2][2][4][2], const Unit& u, int wr, int wc, int fr, int fq) const {
        const int row0 = u.pm * BM + wr * 64 + fr, col0 = u.pn * BM + wc * 32 + 8 * fq;
#pragma unroll
        for (int ai = 0; ai < 2; ++ai)
#pragma unroll
            for (int m = 0; m < 4; ++m) { bf16_t* rowp = O + (size_t)(row0 + ai * HALF + m * 16) * ldc + col0;
#pragma unroll
                for (int bj = 0; bj < 2; ++bj) { const f32x4 v0 = acc[ai][bj][m][0], v1 = acc[ai][bj][m][1];
                    u32x4 w; w.x = cvt_pk_bf16(v0[0], v0[1]); w.y = cvt_pk_bf16(v0[2], v0[3]); w.z = cvt_pk_bf16(v1[0], v1[1]); w.w = cvt_pk_bf16(v1[2], v1[3]);
                    *(u32x4*)(rowp + bj * HALF) = w; } }
    }
};
struct EpiResid {
    static constexpr bool PERM = false;
    float* out; const float* resP; const float* resS; const float* gate;
    __device__ __forceinline__ void operator()(const f32x4 (&acc)[2][2][4][2], const Unit& u, int wr, int wc, int fr, int fq) const {
        const int col0 = u.pn * BM + wc * 32 + 4 * fq;
#pragma unroll
        for (int ai = 0; ai < 2; ++ai) {
            const int rbase = u.pm * BM + ai * HALF + wr * 64;
            const int s = seq_of_row(rbase);
            f32x4 gv[2][2];
#pragma unroll
            for (int bj = 0; bj < 2; ++bj)
#pragma unroll
                for (int n = 0; n < 2; ++n) gv[bj][n] = *(const f32x4*)(gate + (size_t)s * 12288 + col0 + bj * HALF + n * 16);
#pragma unroll
            for (int m = 0; m < 4; ++m) {
                const int r = rbase + m * 16 + fr;
                const float* rp = (resS == nullptr) ? resP + (size_t)r * DM : (r < 8192 ? resP + (size_t)r * DM : resS + (size_t)(r - 8192) * DM);
                float* op = out + (size_t)r * DM;
#pragma unroll
                for (int bj = 0; bj < 2; ++bj)
#pragma unroll
                    for (int n = 0; n < 2; ++n) { const int c = col0 + bj * HALF + n * 16;
                        if (u.part) { const f32x4 v = gv[bj][n] * acc[ai][bj][m][n];
#pragma unroll
                            for (int j = 0; j < 4; ++j) __hip_atomic_fetch_add(op + c + j, v[j], __ATOMIC_RELAXED, __HIP_MEMORY_SCOPE_AGENT); }
                        else { const f32x4 rv = *(const f32x4*)(rp + c); *(f32x4*)(op + c) = rv + gv[bj][n] * acc[ai][bj][m][n]; } }
            }
        }
    }
};
struct EpiUp {
    static constexpr bool PERM = true;
    bf16_t* act; const float* cw; const float* cb; float* headg; float* headv; float* tailg;
    __device__ __forceinline__ void operator()(const f32x4 (&acc)[2][2][4][2], const Unit& u, int wr, int wc, int fr, int fq) const {
        const int tok0 = u.pm * BM + (wr * 16 + fr) * 8;
        const int sc = tok0 >> 6;
        const bool head = (fr & 7) == 0, tail = (fr & 7) == 7;
#pragma unroll
        for (int n = 0; n < 2; ++n) {
            const int ch0 = u.pn * 128 + wc * 32 + 8 * fq + 4 * n;
            const f32x4 w0 = *(const f32x4*)(cw + ch0), w1 = *(const f32x4*)(cw + DFF + ch0), w2 = *(const f32x4*)(cw + 2 * DFF + ch0), bb = *(const f32x4*)(cb + ch0);
            float o[8][4];
#pragma unroll
            for (int j = 0; j < 4; ++j) {
                float g[8], v[8];
#pragma unroll
                for (int k = 0; k < 8; ++k) { g[k] = acc[k >> 2][0][k & 3][n][j]; v[k] = acc[k >> 2][1][k & 3][n][j]; }
                const float p6 = __shfl_up(g[6], 1, 16), p7 = __shfl_up(g[7], 1, 16);
                o[0][j] = siluf(w0[j] * p6 + w1[j] * p7 + w2[j] * g[0] + bb[j]) * v[0];
                o[1][j] = siluf(w0[j] * p7 + w1[j] * g[0] + w2[j] * g[1] + bb[j]) * v[1];
#pragma unroll
                for (int k = 2; k < 8; ++k) o[k][j] = siluf(w0[j] * g[k - 2] + w1[j] * g[k - 1] + w2[j] * g[k] + bb[j]) * v[k];
            }
#pragma unroll
            for (int k = 0; k < 8; ++k) {
                if (k < 2 && head) continue;
                u32x2 w; w.x = cvt_pk_bf16(o[k][0], o[k][1]); w.y = cvt_pk_bf16(o[k][2], o[k][3]);
                *(u32x2*)(act + (size_t)(tok0 + k) * DFF + ch0) = w;
            }
            if (head) {
#pragma unroll
                for (int k = 0; k < 2; ++k) {
                    *(f32x4*)(headg + ((size_t)sc * 2 + k) * DFF + ch0) = (f32x4){acc[0][0][k][n][0], acc[0][0][k][n][1], acc[0][0][k][n][2], acc[0][0][k][n][3]};
                    *(f32x4*)(headv + ((size_t)sc * 2 + k) * DFF + ch0) = (f32x4){acc[0][1][k][n][0], acc[0][1][k][n][1], acc[0][1][k][n][2], acc[0][1][k][n][3]};
                }
            }
            if (tail) {
#pragma unroll
                for (int k = 0; k < 2; ++k)
                    *(f32x4*)(tailg + ((size_t)sc * 2 + k) * DFF + ch0) = (f32x4){acc[1][0][2 + k][n][0], acc[1][0][2 + k][n][1], acc[1][0][2 + k][n][2], acc[1][0][2 + k][n][3]};
            }
        }
    }
};
}

__device__ __forceinline__ float softplusf(float x) { return x > 20.f ? x : log1pf(__expf(x)); }

__device__ __forceinline__ void gdn_prep(CPARAMS p, unsigned char* lds, int sc, int hd) {
    const int tid = threadIdx.x, w = tid >> 6, lane = tid & 63, fr = lane & 15, fq = lane >> 4;
    float* qf = (float*)lds; float* kf = qf + 64 * 129; float* vf = kf + 64 * 129;
    bf16_t* qn = (bf16_t*)(lds + 99072); bf16_t* kn = qn + 64 * 136;
    float* sm = (float*)(lds + 133888); float* beta = sm; float* Gc = sm + 64; float* rq = sm + 128; float* rk = sm + 192; float* gt = sm + 256; float* eg = sm + 320;
    float* Am = qf;
    bf16_t* Abf = (bf16_t*)(lds + 16384);
    bf16_t* WT = (bf16_t*)(lds + 99072);
    const bf16_t* proj = (const bf16_t*)(p.ws + WS_PROJ);
    const float* psm = (const float*)(p.ws + WS_PSMALL);
    const int row0 = sc * 64;
    const bool sample = sc >= 128, first = sample || ((sc & 31) == 0), lastc = sample || ((sc & 31) == 31);
    const int s = sample ? 4 + (sc - 128) : (sc >> 5);
    unsigned char* ops = p.ws + WS_OPS + (size_t)(sc * 12 + 4 + hd) * OPS_UNIT;
    bf16_t* o_wvT = (bf16_t*)ops; bf16_t* o_wk = (bf16_t*)(ops + 16384); bf16_t* o_attn = (bf16_t*)(ops + 32768); bf16_t* o_qg = (bf16_t*)(ops + 40960); bf16_t* o_kgT = (bf16_t*)(ops + 57344);
    float* outc = p.out + (s < 4 ? OUT_P_CONV + (size_t)s * 9216 : OUT_S_CONV + (size_t)(s - 4) * 9216);
    {
        const int d = tid & 127, tg = tid >> 7, t0 = tg * 16;
#pragma unroll
        for (int mat = 0; mat < 3; ++mat) {
            const int pc = PC_GDN_Q + mat * 1024 + hd * 128 + d, cc = mat * 1024 + hd * 128 + d;
            const float w0 = p.gdn_conv_w[cc], w1 = p.gdn_conv_w[3072 + cc], w2 = p.gdn_conv_w[2 * 3072 + cc], w3 = p.gdn_conv_w[3 * 3072 + cc];
            float h[3];
#pragma unroll
            for (int j = 1; j <= 3; ++j) {
                const int tt = t0 - j; float val;
                if (tt >= 0 || !first) val = bf2f(proj[(size_t)(row0 + tt) * NPROJ + pc]);
                else if (sample) val = p.state_gdn_conv[(size_t)(s - 4) * 9216 + (3 + tt) * 3072 + cc];
                else val = 0.f;
                h[j - 1] = val;
            }
            float xm1 = h[0], xm2 = h[1], xm3 = h[2];
            float* dst = mat == 0 ? qf : (mat == 1 ? kf : vf);
            const bf16_t* pr = proj + (size_t)(row0 + t0) * NPROJ + pc;
            bf16_t xr[16];
#pragma unroll
            for (int i = 0; i < 16; ++i) { asm volatile("" : "+v"(pr)); xr[i] = *pr; pr += NPROJ; }
#pragma unroll
            for (int i = 0; i < 16; ++i) {
                const float x0 = bf2f(xr[i]);
                const float y = w0 * xm3 + w1 * xm2 + w2 * xm1 + w3 * x0;
                dst[(t0 + i) * 129 + d] = siluf(y);
                if (lastc && (t0 + i) >= 61) outc[(t0 + i - 61) * 3072 + cc] = x0;
                xm3 = xm2; xm2 = xm1; xm1 = x0;
            }
        }
    }
    __syncthreads();
    {
        const int t = tid >> 3, part = tid & 7; float sq = 0.f, sk = 0.f;
#pragma unroll
        for (int j = 0; j < 16; ++j) { const float a = qf[t * 129 + part * 16 + j], b = kf[t * 129 + part * 16 + j]; sq += a * a; sk += b * b; }
        sq += __shfl_xor(sq, 1); sq += __shfl_xor(sq, 2); sq += __shfl_xor(sq, 4);
        sk += __shfl_xor(sk, 1); sk += __shfl_xor(sk, 2); sk += __shfl_xor(sk, 4);
        if (part == 0) { rq[t] = rsqrtf(sq + EPSF) * 0.08838834764831845f; rk[t] = rsqrtf(sk + EPSF); }
        if (tid < 64) {
            const float* ps = psm + (size_t)(row0 + tid) * 32;
            beta[tid] = 1.f / (1.f + __expf(-ps[16 + hd]));
            gt[tid] = -__expf(p.gdn_a_log[hd]) * softplusf(ps[24 + hd] + p.gdn_dt_bias[hd]);
        }
    }
    __syncthreads();
    if (tid == 0) { float c = 0.f; for (int t = 0; t < 64; ++t) { c += gt[t]; Gc[t] = c; } }
    __syncthreads();
    if (tid < 64) eg[tid] = __expf(Gc[tid]);
    for (int idx = tid; idx < 64 * 128; idx += 512) {
        const int t = idx >> 7, d = idx & 127;
        const float q = qf[t * 129 + d] * rq[t], k = kf[t * 129 + d] * rk[t];
        qn[t * 136 + d] = f2bf(q); kn[t * 136 + d] = f2bf(k); kf[t * 129 + d] = k;
    }
    __syncthreads();
    for (int b = w; b < 32; b += 8) {
        const int which = b >> 4, blk = b & 15, mi = blk >> 2, nj = blk & 3;
        const int i = 16 * mi + fr, j0 = 16 * nj + 4 * fq;
        if (nj > mi) { if (which) *(u32x2*)(o_attn + i * 64 + j0) = (u32x2){0u, 0u}; continue; }
        f32x4 D = {0.f, 0.f, 0.f, 0.f};
        const bf16_t* Z = which ? qn : kn;
#pragma unroll
        for (int ks = 0; ks < 4; ++ks) D = mfma16(ldfrag(kn, 16 * nj + fr, 136, ks * 32 + fq * 8), ldfrag(Z, 16 * mi + fr, 136, ks * 32 + fq * 8), D);
        float r[4];
#pragma unroll
        for (int e = 0; e < 4; ++e) {
            const int j = j0 + e; const float dec = __expf(Gc[i] - Gc[j]);
            if (which) r[e] = (j <= i) ? D[e] * dec : 0.f; else r[e] = (j < i) ? D[e] * dec * beta[i] : 0.f;
        }
        if (which) { u32x2 pk; pk.x = cvt_pk_bf16(r[0], r[1]); pk.y = cvt_pk_bf16(r[2], r[3]); *(u32x2*)(o_attn + i * 64 + j0) = pk; }
        else { *(f32x4*)(Am + i * 64 + j0) = (f32x4){r[0], r[1], r[2], r[3]}; u32x2 pk; pk.x = cvt_pk_bf16(r[0], r[1]); pk.y = cvt_pk_bf16(r[2], r[3]); *(u32x2*)(Abf + i * 72 + j0) = pk; }
    }
    {
        const float Gl = Gc[63];
        for (int idx = tid; idx < 1024; idx += 512) {
            const int t = idx >> 4, d8 = (idx & 15) * 8; const float eg = __expf(Gc[t]);
            float v[8];
#pragma unroll
            for (int j = 0; j < 8; ++j) v[j] = bf2f(qn[t * 136 + d8 + j]) * eg;
            u32x4 pk; pk.x = cvt_pk_bf16(v[0], v[1]); pk.y = cvt_pk_bf16(v[2], v[3]); pk.z = cvt_pk_bf16(v[4], v[5]); pk.w = cvt_pk_bf16(v[6], v[7]);
            *(u32x4*)(o_qg + t * 128 + d8) = pk;
        }
        for (int idx = tid; idx < 1024; idx += 512) {
            const int d = idx >> 3, t8 = (idx & 7) * 8;
            float v[8];
#pragma unroll
            for (int j = 0; j < 8; ++j) v[j] = bf2f(kn[(t8 + j) * 136 + d]) * __expf(Gl - Gc[t8 + j]);
            u32x4 pk; pk.x = cvt_pk_bf16(v[0], v[1]); pk.y = cvt_pk_bf16(v[2], v[3]); pk.z = cvt_pk_bf16(v[4], v[5]); pk.w = cvt_pk_bf16(v[6], v[7]);
            *(u32x4*)(o_kgT + d * 64 + t8) = pk;
        }
        if (tid == 0) ((float*)(p.ws + WS_GLAST))[(size_t)(sc * 12 + 4 + hd) * 128] = __expf(Gl);
    }
    __syncthreads();
    {
        u32x4 z = {0u, 0u, 0u, 0u};
        u32x4* zp = (u32x4*)(WT + (32 * w) * 64 + lane * 32);
        zp[0] = z; zp[1] = z; zp[2] = z; zp[3] = z;
        asm volatile("s_waitcnt lgkmcnt(0)" ::: "memory");
#pragma unroll 1
        for (int b = 0; b < 4; ++b) {
#pragma unroll 1
            for (int cbi = 0; cbi < 2; ++cbi) {
                const int cb = 2 * w + cbi, c = 16 * cb + fr;
                float m4[4];
#pragma unroll
                for (int e = 0; e < 4; ++e) {
                    const int i = 16 * b + 4 * fq + e;
                    m4[e] = (w < 4) ? vf[i * 129 + c] * beta[i] : kf[i * 129 + (c - 128)] * beta[i] * eg[i];
                }
                if (b > 0) {
                    f32x4 D = {0.f, 0.f, 0.f, 0.f};
#pragma unroll
                    for (int ks = 0; ks < 2; ++ks) if (ks == 0 || b == 3) D = mfma16(ldfrag(Abf, 16 * b + fr, 72, ks * 32 + fq * 8), ldfrag(WT, 16 * cb + fr, 64, ks * 32 + fq * 8), D);
#pragma unroll
                    for (int e = 0; e < 4; ++e) m4[e] -= D[e];
                }
                float m[16];
#pragma unroll
                for (int q = 0; q < 4; ++q)
#pragma unroll
                    for (int e = 0; e < 4; ++e) m[4 * q + e] = __shfl(m4[e], fr + 16 * q, 64);
#pragma unroll
                for (int i = 1; i < 16; ++i) {
                    const float* arow = Am + (16 * b + i) * 64 + 16 * b;
                    float r0 = m[i];
                    asm volatile("" : "+v"(r0) :: "memory");
#pragma unroll
                    for (int j = 0; j < i; ++j) r0 -= arow[j] * m[j];
                    m[i] = r0;
                }
                if (fq == 0) {
                    u32x4 p0, p1;
                    p0.x = cvt_pk_bf16(m[0], m[1]); p0.y = cvt_pk_bf16(m[2], m[3]); p0.z = cvt_pk_bf16(m[4], m[5]); p0.w = cvt_pk_bf16(m[6], m[7]);
                    p1.x = cvt_pk_bf16(m[8], m[9]); p1.y = cvt_pk_bf16(m[10], m[11]); p1.z = cvt_pk_bf16(m[12], m[13]); p1.w = cvt_pk_bf16(m[14], m[15]);
                    *(u32x4*)(WT + c * 64 + 16 * b) = p0; *(u32x4*)(WT + c * 64 + 16 * b + 8) = p1;
                }
            }
            asm volatile("s_waitcnt lgkmcnt(0)" ::: "memory");
        }
    }
    __syncthreads();
    for (int idx = tid; idx < 1024; idx += 512) *(u32x4*)(o_wvT + idx * 8) = *(const u32x4*)(WT + idx * 8);
    for (int idx = tid; idx < 1024; idx += 512) {
        const int t = idx >> 4, d8 = (idx & 15) * 8; unsigned short v[8];
#pragma unroll
        for (int j = 0; j < 8; ++j) v[j] = WT[(128 + d8 + j) * 64 + t];
        u32x4 pk; pk.x = v[0] | ((unsigned)v[1] << 16); pk.y = v[2] | ((unsigned)v[3] << 16); pk.z = v[4] | ((unsigned)v[5] << 16); pk.w = v[6] | ((unsigned)v[7] << 16);
        *(u32x4*)(o_wk + t * 128 + d8) = pk;
    }
    __syncthreads();
}

__device__ __forceinline__ void gla_prep(CPARAMS p, unsigned char* lds, int sc, int h) {
    const int tid = threadIdx.x, w = tid >> 6, lane = tid & 63, fr = lane & 15, fq = lane >> 4;
    bf16_t* kraw = (bf16_t*)lds; bf16_t* qraw = (bf16_t*)(lds + 17408); float* Gm = (float*)(lds + 34816);
    bf16_t* qgl = (bf16_t*)(lds + 67840); bf16_t* kdl = (bf16_t*)(lds + 85248); float* alr = (float*)(lds + 102656); float* gsum = (float*)(lds + 106752);
    bf16_t* vl = (bf16_t*)(lds + 108800);
    const bf16_t* proj = (const bf16_t*)(p.ws + WS_PROJ);
    const float* psm = (const float*)(p.ws + WS_PSMALL);
    const int row0 = sc * 64;
    unsigned char* ops = p.ws + WS_OPS + (size_t)(sc * 12 + h) * OPS_UNIT;
    bf16_t* o_vT = (bf16_t*)ops; bf16_t* o_attn = (bf16_t*)(ops + 32768); bf16_t* o_qg = (bf16_t*)(ops + 40960); bf16_t* o_kgT = (bf16_t*)(ops + 57344);
#pragma unroll
    for (int i = 0; i < 2; ++i) { const int idx = tid + 512 * i, t = idx >> 4, seg = idx & 15;
        *(u32x4*)(qraw + t * 136 + seg * 8) = *(const u32x4*)(proj + (size_t)(row0 + t) * NPROJ + PC_GLA_Q + h * 128 + seg * 8);
        *(u32x4*)(kraw + t * 136 + seg * 8) = *(const u32x4*)(proj + (size_t)(row0 + t) * NPROJ + PC_GLA_K + h * 128 + seg * 8); }
#pragma unroll
    for (int i = 0; i < 4; ++i) { const int idx = tid + 512 * i, t = idx >> 5, seg = idx & 31;
        *(u32x4*)(vl + t * 264 + seg * 8) = *(const u32x4*)(proj + (size_t)(row0 + t) * NPROJ + PC_GLA_V + h * 256 + seg * 8); }
    if (tid < 256) { const int t = tid >> 2, q4 = (tid & 3) * 4; *(float4*)(alr + t * 16 + q4) = *(const float4*)(psm + (size_t)(row0 + t) * 32 + q4); }
    __syncthreads();
    const int d = tid & 127, tg = tid >> 7;
    {
        float wg[16];
#pragma unroll
        for (int r = 0; r < 16; ++r) wg[r] = p.gla_wg[r * 512 + h * 128 + d];
        const float bg = p.gla_bg[h * 128 + d];
        float run = 0.f;
#pragma unroll
        for (int i = 0; i < 16; ++i) {
            const int t = tg * 16 + i; float z = bg;
#pragma unroll
            for (int r = 0; r < 16; ++r) z += alr[t * 16 + r] * wg[r];
            const float la = (fminf(z, 0.f) - log1pf(__expf(-fabsf(z)))) * (1.f / 16.f);
            run += la; Gm[t * 129 + d] = run;
        }
        gsum[tg * 128 + d] = run;
    }
    __syncthreads();
    {
        float off = 0.f, Gl = 0.f;
#pragma unroll
        for (int g = 0; g < 4; ++g) { const float v = gsum[g * 128 + d]; if (g < tg) off += v; Gl += v; }
#pragma unroll
        for (int i = 0; i < 16; ++i) {
            const int t = tg * 16 + i; const float G = Gm[t * 129 + d] + off;
            const float q = bf2f(qraw[t * 136 + d]) * 0.08838834764831845f, k = bf2f(kraw[t * 136 + d]);
            qgl[t * 136 + d] = f2bf(q * __expf(G)); kdl[t * 136 + d] = f2bf(k * __expf(-G)); kraw[t * 136 + d] = f2bf(k * __expf(Gl - G));
        }
        if (tg == 0) ((float*)(p.ws + WS_GLAST))[(size_t)(sc * 12 + h) * 128 + d] = __expf(Gl);
    }
    __syncthreads();
#if !defined(GLA_DBG) || GLA_DBG >= 2
#endif
{
    for (int idx = tid; idx < 1024; idx += 512) { const int t = idx >> 4, seg = idx & 15; *(u32x4*)(o_qg + t * 128 + seg * 8) = *(const u32x4*)(qgl + t * 136 + seg * 8); }
#if !defined(GLA_DBG) || GLA_DBG >= 3
    for (int idx = tid; idx < 1024; idx += 512) {
        const int dd = idx >> 3, t8 = (idx & 7) * 8; unsigned short v[8];
#pragma unroll
        for (int j = 0; j < 8; ++j) v[j] = kraw[(t8 + j) * 136 + dd];
        u32x4 pk; pk.x = v[0] | ((unsigned)v[1] << 16); pk.y = v[2] | ((unsigned)v[3] << 16); pk.z = v[4] | ((unsigned)v[5] << 16); pk.w = v[6] | ((unsigned)v[7] << 16);
        *(u32x4*)(o_kgT + dd * 64 + t8) = pk;
    }
    for (int idx = tid; idx < 2048; idx += 512) {
        const int dv = idx >> 3, t8 = (idx & 7) * 8; unsigned short v[8];
#pragma unroll
        for (int j = 0; j < 8; ++j) v[j] = vl[(t8 + j) * 264 + dv];
        u32x4 pk; pk.x = v[0] | ((unsigned)v[1] << 16); pk.y = v[2] | ((unsigned)v[3] << 16); pk.z = v[4] | ((unsigned)v[5] << 16); pk.w = v[6] | ((unsigned)v[7] << 16);
        *(u32x4*)(o_vT + dv * 64 + t8) = pk;
    }
    for (int b = w; b < 16; b += 8) {
        const int mi = b >> 2, nj = b & 3; const int i = 16 * mi + fr, j0 = 16 * nj + 4 * fq;
        if (nj > mi) { *(u32x2*)(o_attn + i * 64 + j0) = (u32x2){0u, 0u}; continue; }
        f32x4 D = {0.f, 0.f, 0.f, 0.f};
#pragma unroll
        for (int ks = 0; ks < 4; ++ks) D = mfma16(ldfrag(kdl, 16 * nj + fr, 136, ks * 32 + fq * 8), ldfrag(qgl, 16 * mi + fr, 136, ks * 32 + fq * 8), D);
        float r[4];
#pragma unroll
        for (int e = 0; e < 4; ++e) r[e] = (j0 + e <= i) ? D[e] : 0.f;
        u32x2 pk; pk.x = cvt_pk_bf16(r[0], r[1]); pk.y = cvt_pk_bf16(r[2], r[3]); *(u32x2*)(o_attn + i * 64 + j0) = pk;
    }
#endif
}
    __syncthreads();
}

__device__ __forceinline__ void phase_chunk_prep(CPARAMS p, unsigned char* lds) {
#ifndef NO_GDN_PREP
    for (int u = blockIdx.x; u < NCHUNK * 8; u += gridDim.x) gdn_prep(p, lds, u >> 3, u & 7);
#endif
    asm volatile("" ::: "memory");
#ifndef NO_GLA_PREP
    for (int u = (blockIdx.x + 128) % gridDim.x; u < NCHUNK * 4; u += gridDim.x) gla_prep(p, lds, u >> 2, u & 3);
#endif
}

__device__ __forceinline__ void gdn_chain(CPARAMS p, unsigned char* lds, int s, int hd) {
    const int tid = threadIdx.x, w = tid >> 6, lane = tid & 63, fr = lane & 15, fq = lane >> 4;
    bf16_t* Wk = (bf16_t*)lds; bf16_t* qg = (bf16_t*)(lds + 17408); bf16_t* attn = (bf16_t*)(lds + 34816); bf16_t* kgT = (bf16_t*)(lds + 44032);
    bf16_t* WvT = (bf16_t*)(lds + 62464); bf16_t* ST = (bf16_t*)(lds + 80896); bf16_t* uT = (bf16_t*)(lds + 115712); float* red = (float*)(lds + 134144);
    const int nch = s < 4 ? 32 : 1, sc0 = s < 4 ? s * 32 : 128 + (s - 4);
    const bf16_t* proj = (const bf16_t*)(p.ws + WS_PROJ);
    bf16_t* mixo = (bf16_t*)(p.ws + WS_MIXO);
    const float* glast = (const float*)(p.ws + WS_GLAST);
    const int dvr = 16 * w + fr;
    f32x4 sacc[8];
#pragma unroll
    for (int nb = 0; nb < 8; ++nb) {
        if (s >= 4) {
            const float* st = p.state_gdn + (size_t)((s - 4) * 8 + hd) * 16384 + (size_t)(16 * nb + 4 * fq) * 128 + dvr;
            asm volatile("" : "+v"(st));
#pragma unroll
            for (int e = 0; e < 4; ++e) sacc[nb][e] = st[e * 128];
        } else sacc[nb] = (f32x4){0.f, 0.f, 0.f, 0.f};
        u32x2 pk; pk.x = cvt_pk_bf16(sacc[nb][0], sacc[nb][1]); pk.y = cvt_pk_bf16(sacc[nb][2], sacc[nb][3]);
        *(u32x2*)(ST + dvr * 136 + 16 * nb + 4 * fq) = pk;
    }
    u32x4 pf[9];
    {
        const u32x4* src = (const u32x4*)(p.ws + WS_OPS + (size_t)(sc0 * 12 + 4 + hd) * OPS_UNIT);
#pragma unroll
        for (int i = 0; i < 9; ++i) pf[i] = src[tid + 512 * i];
    }
    for (int c = 0; c < nch; ++c) {
        const int sc = sc0 + c; int row0 = sc * 64; asm volatile("" : "+v"(row0));
#pragma unroll
        for (int i = 0; i < 9; ++i) {
            const int q = tid + 512 * i;
            bf16_t* dst;
            if (i < 2) dst = WvT + (q >> 3) * 72 + (q & 7) * 8;
            else if (i < 4) { const int q2 = q - 1024; dst = Wk + (q2 >> 4) * 136 + (q2 & 15) * 8; }
            else if (i < 5) { const int q2 = q - 2048; dst = attn + (q2 >> 3) * 72 + (q2 & 7) * 8; }
            else if (i < 7) { const int q2 = q - 2560; dst = qg + (q2 >> 4) * 136 + (q2 & 15) * 8; }
            else { const int q2 = q - 3584; dst = kgT + (q2 >> 3) * 72 + (q2 & 7) * 8; }
            *(u32x4*)dst = pf[i];
        }
        const float decay = glast[(size_t)(sc * 12 + 4 + hd) * 128];
        __syncthreads();
        u32x2 gtv[4];
#pragma unroll
        for (int tb = 0; tb < 4; ++tb) gtv[tb] = *(const u32x2*)(proj + (size_t)(row0 + 16 * tb + fr) * NPROJ + PC_GDN_G + hd * 128 + 16 * w + 4 * fq);
        if (c + 1 < nch) {
            const u32x4* src = (const u32x4*)(p.ws + WS_OPS + (size_t)((sc + 1) * 12 + 4 + hd) * OPS_UNIT);
#pragma unroll
            for (int i = 0; i < 9; ++i) pf[i] = src[tid + 512 * i];
        }
        bf16x8 stf[4];
#pragma unroll
        for (int ks = 0; ks < 4; ++ks) stf[ks] = ldfrag(ST, dvr, 136, ks * 32 + fq * 8);
#pragma unroll
        for (int tb = 0; tb < 4; ++tb) {
            f32x4 D = {0.f, 0.f, 0.f, 0.f};
#pragma unroll
            for (int ks = 0; ks < 4; ++ks) D = mfma16(ldfrag(Wk, 16 * tb + fr, 136, ks * 32 + fq * 8), stf[ks], D);
            const u32x2 wv = *(const u32x2*)(WvT + dvr * 72 + 16 * tb + 4 * fq);
            u32x2 pk; pk.x = cvt_pk_bf16(bflo(wv.x) - D[0], bfhi(wv.x) - D[1]); pk.y = cvt_pk_bf16(bflo(wv.y) - D[2], bfhi(wv.y) - D[3]);
            *(u32x2*)(uT + dvr * 72 + 16 * tb + 4 * fq) = pk;
        }
        asm volatile("s_waitcnt lgkmcnt(0)" ::: "memory");
        bf16x8 utf[2];
#pragma unroll
        for (int ks = 0; ks < 2; ++ks) utf[ks] = ldfrag(uT, dvr, 72, ks * 32 + fq * 8);
        f32x4 o[4];
#pragma unroll
        for (int tb = 0; tb < 4; ++tb) {
            f32x4 D = {0.f, 0.f, 0.f, 0.f};
#pragma unroll
            for (int ks = 0; ks < 4; ++ks) D = mfma16(stf[ks], ldfrag(qg, 16 * tb + fr, 136, ks * 32 + fq * 8), D);
#pragma unroll
            for (int ks = 0; ks < 2; ++ks) D = mfma16(utf[ks], ldfrag(attn, 16 * tb + fr, 72, ks * 32 + fq * 8), D);
            o[tb] = D;
            float ss = D[0] * D[0] + D[1] * D[1] + D[2] * D[2] + D[3] * D[3];
            ss += __shfl_xor(ss, 16); ss += __shfl_xor(ss, 32);
            if (fq == 0) red[w * 64 + 16 * tb + fr] = ss;
        }
#pragma unroll
        for (int nb = 0; nb < 8; ++nb) {
            f32x4 a = sacc[nb] * decay;
#pragma unroll
            for (int ks = 0; ks < 2; ++ks) a = mfma16(ldfrag(kgT, 16 * nb + fr, 72, ks * 32 + fq * 8), utf[ks], a);
            sacc[nb] = a;
            u32x2 pk; pk.x = cvt_pk_bf16(a[0], a[1]); pk.y = cvt_pk_bf16(a[2], a[3]);
            *(u32x2*)(ST + dvr * 136 + 16 * nb + 4 * fq) = pk;
        }
        __syncthreads();
        {
            const int dv0 = 16 * w + 4 * fq;
            const f32x4 nrm = *(const f32x4*)(p.gdn_norm + dv0);
#pragma unroll
            for (int tb = 0; tb < 4; ++tb) {
                const int t = 16 * tb + fr; float tot = 0.f;
#pragma unroll
                for (int i = 0; i < 8; ++i) tot += red[i * 64 + t];
                const float rstd = rsqrtf(tot * (1.f / 128.f) + EPSF);
                const size_t row = (size_t)(row0 + t);
                const u32x2 gt = gtv[tb];
                const float g0 = siluf(bflo(gt.x)), g1 = siluf(bfhi(gt.x)), g2 = siluf(bflo(gt.y)), g3 = siluf(bfhi(gt.y));
                u32x2 pk; pk.x = cvt_pk_bf16(o[tb][0] * rstd * nrm[0] * g0, o[tb][1] * rstd * nrm[1] * g1); pk.y = cvt_pk_bf16(o[tb][2] * rstd * nrm[2] * g2, o[tb][3] * rstd * nrm[3] * g3);
                *(u32x2*)(mixo + row * DM + 1024 + hd * 128 + dv0) = pk;
            }
        }
        __syncthreads();
    }
    float* so = p.out + (s < 4 ? OUT_P_GDN + (size_t)(s * 8 + hd) * 16384 : OUT_S_GDN + (size_t)((s - 4) * 8 + hd) * 16384);
#pragma unroll
    for (int nb = 0; nb < 8; ++nb)
        { float* q = so + (size_t)(16 * nb + 4 * fq) * 128 + dvr; asm volatile("" : "+v"(q));
#pragma unroll
          for (int e = 0; e < 4; ++e) q[e * 128] = sacc[nb][e]; }
}

__device__ __forceinline__ void gla_chain(CPARAMS p, unsigned char* lds, int s, int h) {
    const int tid = threadIdx.x, w = tid >> 6, lane = tid & 63, fr = lane & 15, fq = lane >> 4;
    bf16_t* qg = (bf16_t*)lds; bf16_t* attn = (bf16_t*)(lds + 17408); bf16_t* kgT = (bf16_t*)(lds + 26624); bf16_t* vT = (bf16_t*)(lds + 45056);
    bf16_t* ST = (bf16_t*)(lds + 81920); float* red = (float*)(lds + 151552); float* gl = (float*)(lds + 153600);
    const int nch = s < 4 ? 32 : 1, sc0 = s < 4 ? s * 32 : 128 + (s - 4);
    const bf16_t* proj = (const bf16_t*)(p.ws + WS_PROJ);
    bf16_t* mixo = (bf16_t*)(p.ws + WS_MIXO);
    const float* glast = (const float*)(p.ws + WS_GLAST);
    f32x4 sacc[2][8];
#pragma unroll
    for (int db = 0; db < 2; ++db) {
        const int dvr = 32 * w + 16 * db + fr;
#pragma unroll
        for (int nb = 0; nb < 8; ++nb) {
            if (s >= 4) {
                const float* st = p.state_gla + (size_t)((s - 4) * 4 + h) * 32768 + (size_t)(16 * nb + 4 * fq) * 256 + dvr;
                asm volatile("" : "+v"(st));
#pragma unroll
                for (int e = 0; e < 4; ++e) sacc[db][nb][e] = st[e * 256];
            } else sacc[db][nb] = (f32x4){0.f, 0.f, 0.f, 0.f};
            u32x2 pk; pk.x = cvt_pk_bf16(sacc[db][nb][0], sacc[db][nb][1]); pk.y = cvt_pk_bf16(sacc[db][nb][2], sacc[db][nb][3]);
            *(u32x2*)(ST + dvr * 136 + 16 * nb + 4 * fq) = pk;
        }
    }
    u32x4 pf[9]; float glp = 0.f;
    {
        const u32x4* src = (const u32x4*)(p.ws + WS_OPS + (size_t)(sc0 * 12 + h) * OPS_UNIT);
#pragma unroll
        for (int i = 0; i < 9; ++i) pf[i] = src[tid + 512 * i];
        if (tid < 128) glp = glast[(size_t)(sc0 * 12 + h) * 128 + tid];
    }
    for (int c = 0; c < nch; ++c) {
        const int sc = sc0 + c; int row0 = sc * 64; asm volatile("" : "+v"(row0));
#pragma unroll
        for (int i = 0; i < 9; ++i) {
            const int q = tid + 512 * i;
            bf16_t* dst;
            if (i < 4) dst = vT + (q >> 3) * 72 + (q & 7) * 8;
            else if (i < 5) { const int q2 = q - 2048; dst = attn + (q2 >> 3) * 72 + (q2 & 7) * 8; }
            else if (i < 7) { const int q2 = q - 2560; dst = qg + (q2 >> 4) * 136 + (q2 & 15) * 8; }
            else { const int q2 = q - 3584; dst = kgT + (q2 >> 3) * 72 + (q2 & 7) * 8; }
            *(u32x4*)dst = pf[i];
        }
        if (tid < 128) gl[tid] = glp;
        __syncthreads();
        f32x4 o[2][4];
        float ssum[4] = {0.f, 0.f, 0.f, 0.f};
        bf16x8 vtf[2][2];
#pragma unroll
        for (int db = 0; db < 2; ++db) {
            asm volatile("" ::: "memory");
            const int dvr = 32 * w + 16 * db + fr;
            bf16x8 stf[4];
#pragma unroll
            for (int ks = 0; ks < 4; ++ks) stf[ks] = ldfrag(ST, dvr, 136, ks * 32 + fq * 8);
#pragma unroll
            for (int ks = 0; ks < 2; ++ks) vtf[db][ks] = ldfrag(vT, dvr, 72, ks * 32 + fq * 8);
#pragma unroll
            for (int tb = 0; tb < 4; ++tb) {
                f32x4 D = {0.f, 0.f, 0.f, 0.f};
#pragma unroll
                for (int ks = 0; ks < 4; ++ks) D = mfma16(stf[ks], ldfrag(qg, 16 * tb + fr, 136, ks * 32 + fq * 8), D);
#pragma unroll
                for (int ks = 0; ks < 2; ++ks) D = mfma16(vtf[db][ks], ldfrag(attn, 16 * tb + fr, 72, ks * 32 + fq * 8), D);
                o[db][tb] = D;
                ssum[tb] += D[0] * D[0] + D[1] * D[1] + D[2] * D[2] + D[3] * D[3];
            }
        }
#pragma unroll
        for (int tb = 0; tb < 4; ++tb) { float ss = ssum[tb]; ss += __shfl_xor(ss, 16); ss += __shfl_xor(ss, 32); if (fq == 0) red[w * 64 + 16 * tb + fr] = ss; }
        asm volatile("" ::: "memory");
        if (c + 1 < nch) {
            const u32x4* src = (const u32x4*)(p.ws + WS_OPS + (size_t)((sc + 1) * 12 + h) * OPS_UNIT);
#pragma unroll
            for (int i = 0; i < 9; ++i) pf[i] = src[tid + 512 * i];
            if (tid < 128) glp = glast[(size_t)((sc + 1) * 12 + h) * 128 + tid];
        }
#pragma unroll
        for (int nb = 0; nb < 8; ++nb) {
            const f32x4 dec = *(const f32x4*)(gl + 16 * nb + 4 * fq);
            bf16x8 kf0 = ldfrag(kgT, 16 * nb + fr, 72, fq * 8), kf1 = ldfrag(kgT, 16 * nb + fr, 72, 32 + fq * 8);
#pragma unroll
            for (int db = 0; db < 2; ++db) {
                const int dvr = 32 * w + 16 * db + fr;
                f32x4 a = sacc[db][nb] * dec;
                a = mfma16(kf0, vtf[db][0], a); a = mfma16(kf1, vtf[db][1], a);
                sacc[db][nb] = a;
                u32x2 pk; pk.x = cvt_pk_bf16(a[0], a[1]); pk.y = cvt_pk_bf16(a[2], a[3]);
                *(u32x2*)(ST + dvr * 136 + 16 * nb + 4 * fq) = pk;
            }
        }
        __syncthreads();
#pragma unroll
        for (int tb = 0; tb < 4; ++tb) {
            const int t = 16 * tb + fr; float tot = 0.f;
#pragma unroll
            for (int i = 0; i < 8; ++i) tot += red[i * 64 + t];
            const float rstd = rsqrtf(tot * (1.f / 256.f) + EPSF);
            const size_t row = (size_t)(row0 + t);
#pragma unroll
            for (int db = 0; db < 2; ++db) {
                const int dv0 = 32 * w + 16 * db + 4 * fq;
                const f32x4 nrm = *(const f32x4*)(p.gla_norm + dv0);
                const u32x2 gt = *(const u32x2*)(proj + row * NPROJ + PC_GLA_R + h * 256 + dv0);
                const float g0 = siluf(bflo(gt.x)), g1 = siluf(bfhi(gt.x)), g2 = siluf(bflo(gt.y)), g3 = siluf(bfhi(gt.y));
                const f32x4 ov = o[db][tb];
                u32x2 pk; pk.x = cvt_pk_bf16(ov[0] * rstd * nrm[0] * g0, ov[1] * rstd * nrm[1] * g1); pk.y = cvt_pk_bf16(ov[2] * rstd * nrm[2] * g2, ov[3] * rstd * nrm[3] * g3);
                *(u32x2*)(mixo + row * DM + h * 256 + dv0) = pk;
            }
        }
        __syncthreads();
    }
    float* so = p.out + (s < 4 ? OUT_P_GLA + (size_t)(s * 4 + h) * 32768 : OUT_S_GLA + (size_t)((s - 4) * 4 + h) * 32768);
#pragma unroll
    for (int db = 0; db < 2; ++db)
#pragma unroll
        for (int nb = 0; nb < 8; ++nb)
            { float* q = so + (size_t)(16 * nb + 4 * fq) * 256 + 32 * w + 16 * db + fr; asm volatile("" : "+v"(q));
#pragma unroll
              for (int e = 0; e < 4; ++e) q[e * 256] = sacc[db][nb][e]; }
}

__device__ __forceinline__ void phase_recur(CPARAMS p, unsigned char* lds) {
#ifndef NO_GLA_CHAIN
    for (int u = blockIdx.x; u < 240; u += gridDim.x) {
        if (u < 16) gla_chain(p, lds, u >> 2, u & 3);
        else if (u >= 48 && u < 112) gla_chain(p, lds, 4 + ((u - 48) >> 2), (u - 48) & 3);
        else continue;
        __syncthreads();
    }
#endif
    asm volatile("" ::: "memory");
#ifndef NO_GDN_CHAIN
    for (int u = blockIdx.x; u < 240; u += gridDim.x) {
        if (u >= 16 && u < 48) gdn_chain(p, lds, (u - 16) >> 3, (u - 16) & 7);
        else if (u >= 112) gdn_chain(p, lds, 4 + ((u - 112) >> 3), (u - 112) & 7);
        else continue;
        __syncthreads();
    }
#endif
}

__device__ __forceinline__ void phase_halo(CPARAMS p) {
    const float* headg = (const float*)(p.ws + WS_HEADG); const float* headv = (const float*)(p.ws + WS_HEADV); const float* tailg = (const float*)(p.ws + WS_TAILG);
    bf16_t* act = (bf16_t*)(p.ws + WS_ACT);
    for (int idx = blockIdx.x * 512 + threadIdx.x; idx < NCHUNK * DFF; idx += gridDim.x * 512) {
        const int sc = idx / DFF, ch = idx % DFF;
        const bool sample = sc >= 128, first = sample || ((sc & 31) == 0), lastc = sample || ((sc & 31) == 31);
        const int s = sample ? 4 + (sc - 128) : (sc >> 5);
        float gm2, gm1;
        if (!first) { gm2 = tailg[((size_t)(sc - 1) * 2 + 0) * DFF + ch]; gm1 = tailg[((size_t)(sc - 1) * 2 + 1) * DFF + ch]; }
        else if (sample) { gm2 = p.state_ffn_conv[(size_t)(s - 4) * 11264 + ch]; gm1 = p.state_ffn_conv[(size_t)(s - 4) * 11264 + DFF + ch]; }
        else { gm2 = 0.f; gm1 = 0.f; }
        const float g0 = headg[((size_t)sc * 2) * DFF + ch], g1 = headg[((size_t)sc * 2 + 1) * DFF + ch];
        const float v0 = headv[((size_t)sc * 2) * DFF + ch], v1 = headv[((size_t)sc * 2 + 1) * DFF + ch];
        const float w0 = p.ffn_conv_w[ch], w1 = p.ffn_conv_w[DFF + ch], w2 = p.ffn_conv_w[2 * DFF + ch], bb = p.ffn_conv_b[ch];
        act[(size_t)(sc * 64) * DFF + ch] = f2bf(siluf(w0 * gm2 + w1 * gm1 + w2 * g0 + bb) * v0);
        act[(size_t)(sc * 64 + 1) * DFF + ch] = f2bf(siluf(w0 * gm1 + w1 * g0 + w2 * g1 + bb) * v1);
        if (lastc) {
            float* of = p.out + (s < 4 ? OUT_P_FFN + (size_t)s * 11264 : OUT_S_FFN + (size_t)(s - 4) * 11264);
            of[ch] = tailg[((size_t)sc * 2) * DFF + ch]; of[DFF + ch] = tailg[((size_t)sc * 2 + 1) * DFF + ch];
        }
    }
}

constexpr int NPHASE = 11;
#ifdef ONLY_PHASE
#define PH_EN(n) ((n) == ONLY_PHASE)
#else
#define PH_EN(n) true
#endif
__global__ void __launch_bounds__(512) fwd_megakernel(Params p_) {
    typedef const __attribute__((address_space(4))) Params* KP;
    KP pp0 = (KP)__builtin_amdgcn_kernarg_segment_ptr();
    const int ph_lo_ = p_.ph_lo, ph_hi_ = p_.ph_hi;
#define p (*({ KP q_ = pp0; asm volatile("" : "+s"(q_)); q_; }))
    extern __shared__ __attribute__((aligned(16))) unsigned char shm[];
    cg::grid_group grid = cg::this_grid();
    const bool multi = (ph_hi_ - ph_lo_) > 1;
#define PH_ON(n) (PH_EN(n) && ph_lo_ <= (n) && (n) < ph_hi_)
#ifndef DUP_MASK
#define DUP_MASK 0
#endif
#define DUP_N(n) (((DUP_MASK) >> (n)) & 1 ? 2 : 1)
#define PH_SYNC(n) do { if (multi && (n) + 1 < ph_hi_ && (n) >= ph_lo_) { __threadfence(); grid.sync(); } } while (0)
    if (PH_ON(0)) phase_prep(p, shm);
#if (DUP_MASK >> 0) & 1
    __threadfence(); grid.sync();
    if (PH_ON(0)) phase_prep(p, shm);
#endif
    PH_SYNC(0);
    if (PH_ON(1)) norm_phase<0>(p, shm);
#if (DUP_MASK >> 1) & 1
    __threadfence(); grid.sync();
    if (PH_ON(1)) norm_phase<0>(p, shm);
#endif
    PH_SYNC(1);
    if (PH_ON(2)) { pg8::Gemm g{(const bf16_t*)(p.ws + WS_H1), (const bf16_t*)(p.ws + WS_WT_IN), T_ROWS, NPROJ, DM}; pg8::StaticOrder S; S.init(g.M, g.N, (int)gridDim.x, (int)blockIdx.x, g.K, 0); pg8::EpiProj E{(bf16_t*)(p.ws + WS_PROJ), NPROJ}; pg8::gemm_phase((LAS unsigned char*)shm, g, S, E); }
#if (DUP_MASK >> 2) & 1
    __threadfence(); grid.sync();
    if (PH_ON(2)) { pg8::Gemm g{(const bf16_t*)(p.ws + WS_H1), (const bf16_t*)(p.ws + WS_WT_IN), T_ROWS, NPROJ, DM}; pg8::StaticOrder S; S.init(g.M, g.N, (int)gridDim.x, (int)blockIdx.x, g.K, 0); pg8::EpiProj E{(bf16_t*)(p.ws + WS_PROJ), NPROJ}; pg8::gemm_phase((LAS unsigned char*)shm, g, S, E); }
#endif
    PH_SYNC(2);
    if (PH_ON(3)) phase_chunk_prep(p, shm);
#if (DUP_MASK >> 3) & 1
    __threadfence(); grid.sync();
    if (PH_ON(3)) phase_chunk_prep(p, shm);
#endif
    PH_SYNC(3);
    if (PH_ON(4)) phase_recur(p, shm);
#if (DUP_MASK >> 4) & 1
    __threadfence(); grid.sync();
    if (PH_ON(4)) phase_recur(p, shm);
#endif
    PH_SYNC(4);
    if (PH_ON(5)) { pg8::Gemm g{(const bf16_t*)(p.ws + WS_MIXO), (const bf16_t*)(p.ws + WS_WT_OUT), T_ROWS, DM, DM}; pg8::StaticOrder S; S.init(g.M, g.N, (int)gridDim.x, (int)blockIdx.x, g.K, 0); pg8::EpiResid E{(float*)(p.ws + WS_X1), p.x_prompt, p.x_sample, (const float*)(p.ws + WS_MOD) + 4096}; pg8::gemm_phase((LAS unsigned char*)shm, g, S, E); }
#if (DUP_MASK >> 5) & 1
    __threadfence(); grid.sync();
    if (PH_ON(5)) { pg8::Gemm g{(const bf16_t*)(p.ws + WS_MIXO), (const bf16_t*)(p.ws + WS_WT_OUT), T_ROWS, DM, DM}; pg8::StaticOrder S; S.init(g.M, g.N, (int)gridDim.x, (int)blockIdx.x, g.K, 0); pg8::EpiResid E{(float*)(p.ws + WS_X1), p.x_prompt, p.x_sample, (const float*)(p.ws + WS_MOD) + 4096}; pg8::gemm_phase((LAS unsigned char*)shm, g, S, E); }
#endif
    PH_SYNC(5);
    if (PH_ON(6)) norm_phase<1>(p, shm);
#if (DUP_MASK >> 6) & 1
    __threadfence(); grid.sync();
    if (PH_ON(6)) norm_phase<1>(p, shm);
#endif
    PH_SYNC(6);
    if (PH_ON(7)) { pg8::Gemm g{(const bf16_t*)(p.ws + WS_H2), (const bf16_t*)(p.ws + WS_WT_UP), T_ROWS, NUP, DM}; pg8::StaticOrder S; S.init(g.M, g.N, (int)gridDim.x, (int)blockIdx.x, g.K, 0); pg8::EpiUp E{(bf16_t*)(p.ws + WS_ACT), p.ffn_conv_w, p.ffn_conv_b, (float*)(p.ws + WS_HEADG), (float*)(p.ws + WS_HEADV), (float*)(p.ws + WS_TAILG)}; pg8::gemm_phase((LAS unsigned char*)shm, g, S, E); }
#if (DUP_MASK >> 7) & 1
    __threadfence(); grid.sync();
    if (PH_ON(7)) { pg8::Gemm g{(const bf16_t*)(p.ws + WS_H2), (const bf16_t*)(p.ws + WS_WT_UP), T_ROWS, NUP, DM}; pg8::StaticOrder S; S.init(g.M, g.N, (int)gridDim.x, (int)blockIdx.x, g.K, 0); pg8::EpiUp E{(bf16_t*)(p.ws + WS_ACT), p.ffn_conv_w, p.ffn_conv_b, (float*)(p.ws + WS_HEADG), (float*)(p.ws + WS_HEADV), (float*)(p.ws + WS_TAILG)}; pg8::gemm_phase((LAS unsigned char*)shm, g, S, E); }
#endif
    PH_SYNC(7);
    if (PH_ON(8)) phase_halo(p);
#if (DUP_MASK >> 8) & 1
    __threadfence(); grid.sync();
    if (PH_ON(8)) phase_halo(p);
#endif
    PH_SYNC(8);
    if (PH_ON(9)) { pg8::Gemm g{(const bf16_t*)(p.ws + WS_ACT), (const bf16_t*)(p.ws + WS_WT_DOWN), T_ROWS, DM, DFF}; pg8::StaticOrder S; S.init(g.M, g.N, (int)gridDim.x, (int)blockIdx.x, g.K, 4); pg8::EpiResid E{(float*)(p.ws + WS_X1), (const float*)(p.ws + WS_X1), nullptr, (const float*)(p.ws + WS_MOD) + 10240}; pg8::gemm_phase((LAS unsigned char*)shm, g, S, E); }
#if (DUP_MASK >> 9) & 1
    __threadfence(); grid.sync();
    if (PH_ON(9)) { pg8::Gemm g{(const bf16_t*)(p.ws + WS_ACT), (const bf16_t*)(p.ws + WS_WT_DOWN), T_ROWS, DM, DFF}; pg8::StaticOrder S; S.init(g.M, g.N, (int)gridDim.x, (int)blockIdx.x, g.K, 4); pg8::EpiResid E{(float*)(p.ws + WS_X1), (const float*)(p.ws + WS_X1), nullptr, (const float*)(p.ws + WS_MOD) + 10240}; pg8::gemm_phase((LAS unsigned char*)shm, g, S, E); }
#endif
    PH_SYNC(9);
    if (PH_ON(10)) norm_phase<2>(p, shm);
#if (DUP_MASK >> 10) & 1
    __threadfence(); grid.sync();
    if (PH_ON(10)) norm_phase<2>(p, shm);
#endif
#undef p
}


#ifdef DBG_STOP
__global__ void dbg_digest(const unsigned short* ws16, size_t L, float* out, size_t n) {
    for (size_t i = (size_t)blockIdx.x * blockDim.x + threadIdx.x; i < n; i += (size_t)gridDim.x * blockDim.x) {
        unsigned sum = 0; for (size_t j = i; j < L; j += n) sum += ws16[j];
        out[i] = (float)sum;
    }
}
#endif
#ifndef MK_MULTI_LAUNCH
#define MK_MULTI_LAUNCH 0
#endif

extern "C" void kernel_launch(void* const* d_in, const int* in_sizes, int n_in, void* d_out, int out_size, void* d_ws, size_t ws_size, hipStream_t stream) {
    static int grid_blocks = 0;
    if (grid_blocks == 0) {
        if (n_in != 26 || (size_t)out_size != OUT_TOTAL || ws_size < WS_END) {
            fprintf(stderr, "kernel_launch: unexpected shapes: n_in %d out %d ws %zu (need %zu); nothing launched\n", n_in, out_size, ws_size, (size_t)WS_END); grid_blocks = -1; return; }
        int dev = 0, cus = 0, per_cu = 0;
        hipGetDevice(&dev);
        hipDeviceGetAttribute(&cus, hipDeviceAttributeMultiprocessorCount, dev);
        if (hipFuncSetAttribute((const void*)fwd_megakernel, hipFuncAttributeMaxDynamicSharedMemorySize, LDS_BYTES) != hipSuccess) { fprintf(stderr, "kernel_launch: hipFuncSetAttribute failed\n"); grid_blocks = -1; return; }
        if (hipOccupancyMaxActiveBlocksPerMultiprocessor(&per_cu, (const void*)fwd_megakernel, 512, LDS_BYTES) != hipSuccess || per_cu < 1) { fprintf(stderr, "kernel_launch: occupancy query failed (%d)\n", per_cu); grid_blocks = -1; return; }
        grid_blocks = cus * per_cu;
    }
    if (grid_blocks < 0) return;
    Params p{};
    const float** pp = (const float**)&p;
    for (int i = 0; i < 26; ++i) pp[i] = (const float*)d_in[i];
    p.out = (float*)d_out; p.ws = (unsigned char*)d_ws;
#if MK_MULTI_LAUNCH
#ifdef DBG_STOP
    for (int ph = 0; ph <= DBG_STOP; ++ph) { p.ph_lo = ph; p.ph_hi = ph + 1; hipLaunchKernelGGL(fwd_megakernel, dim3(grid_blocks), dim3(512), LDS_BYTES, stream, p); }
    hipLaunchKernelGGL(dbg_digest, dim3(2048), dim3(256), 0, stream, (const unsigned short*)d_ws, (size_t)(WS_END / 2), (float*)d_out, (size_t)OUT_TOTAL);
#else
    for (int ph = 0; ph < NPHASE; ++ph) { p.ph_lo = ph; p.ph_hi = ph + 1; hipLaunchKernelGGL(fwd_megakernel, dim3(grid_blocks), dim3(512), LDS_BYTES, stream, p); }
#endif
#else
    p.ph_lo = 0; p.ph_hi = NPHASE;
    void* args[] = {&p};
    hipError_t e = hipLaunchCooperativeKernel((void*)fwd_megakernel, dim3(grid_blocks), dim3(512), args, LDS_BYTES, stream);
    if (e != hipSuccess) fprintf(stderr, "cooperative launch failed: %s (grid %d)\n", hipGetErrorString(e), grid_blocks);
#endif
}
```
